# Optimizing an MI355X kernel written in HIP

```python
import math
import jax, jax.numpy as jnp
from jax import lax
import numpy as np

D_MODEL = 1024
BATCH = 32
SEQ = 256
DEPTH = 2
DEC_BATCH = 8
DEC_SEQ = 4096
PAST_LEN = 256

GRID_W = 64
EPS = 1e-6
ROPE_BASE = 10000.0
BLOCK = 128
DN_HEADS = 4
DN_DK = 128
DN_DV = 128
DN_CONV = 3
DN_CHUNK = 64
MLA_HEADS = 4
MLA_Q_LORA = 256
MLA_KV_LORA = 128
MLA_NOPE = 64
MLA_ROPE = 32
MLA_V = 64
SWA_HEADS = 4
SWA_KV_HEADS = 2
SWA_HD = 64
WINDOW = 128
D_FF = 4 * D_MODEL
N_MOD = 6

DN_CONV_CH = 2 * DN_HEADS * DN_DK + DN_HEADS * DN_DV
IN_SPLITS = (DN_CONV_CH, DN_HEADS * DN_DV, DN_HEADS, DN_HEADS, DN_HEADS, DN_HEADS,
             MLA_Q_LORA, MLA_KV_LORA, MLA_ROPE,
             SWA_HEADS * SWA_HD, SWA_KV_HEADS * SWA_HD, SWA_KV_HEADS * SWA_HD)
IN_W = sum(IN_SPLITS)
MIX_W = DN_HEADS * DN_DV + MLA_HEADS * MLA_V + SWA_HEADS * SWA_HD
MLA_SCALE = (MLA_NOPE + MLA_ROPE) ** -0.5
SWA_SCALE = SWA_HD ** -0.5

kernel_name = 'hybrid_flow_prefix_step'


def _rms_norm(x, g):
    xf = x.astype(jnp.float32)
    y = xf * lax.rsqrt(jnp.mean(xf * xf, axis=-1, keepdims=True) + EPS)
    return (y * g.astype(jnp.float32)).astype(x.dtype)


def _l2norm(x):
    xf = x.astype(jnp.float32)
    return xf * lax.rsqrt(jnp.sum(xf * xf, axis=-1, keepdims=True) + EPS)


def _axial_rope_tables(n_tok, rot_dim):
    rows = n_tok // GRID_W
    row = jnp.repeat(jnp.arange(rows, dtype=jnp.float32), GRID_W)
    col = jnp.tile(jnp.arange(GRID_W, dtype=jnp.float32), rows)
    n_freq = rot_dim // 4
    inv_freq = ROPE_BASE ** (-jnp.arange(n_freq, dtype=jnp.float32) / n_freq)
    ang = jnp.concatenate([row[:, None] * inv_freq, col[:, None] * inv_freq], axis=-1)
    return jnp.cos(ang), jnp.sin(ang)


def _apply_rope(x, cos, sin):
    xf = x.astype(jnp.float32)
    x1, x2 = jnp.split(xf, 2, axis=-1)
    c = cos[:, None, :]
    s = sin[:, None, :]
    return jnp.concatenate([x1 * c - x2 * s, x1 * s + x2 * c], axis=-1).astype(x.dtype)


def _short_conv(x, w):
    y = lax.conv_general_dilated(x, w[:, None, :].astype(x.dtype), window_strides=(1,),
                                 padding=[(DN_CONV // 2, DN_CONV // 2)],
                                 dimension_numbers=('NWC', 'WIO', 'NWC'),
                                 feature_group_count=x.shape[-1])
    return jax.nn.silu(y)


def _gdn_chunked(q, k, v, g, beta, s0):
    B, T, H, DK = q.shape
    DV = v.shape[-1]
    C = DN_CHUNK
    N = T // C
    f32 = jnp.float32

    def chunks(t):
        t = t.astype(f32).reshape((B, N, C, H) + t.shape[3:])
        return jnp.moveaxis(t, (1, 3), (0, 2))

    qc, kc, vc = chunks(q), chunks(k), chunks(v)
    gc = jnp.cumsum(chunks(g), axis=-1)
    bc = chunks(beta)
    idx = jnp.arange(C)
    incl = idx[:, None] >= idx[None, :]
    strict = idx[:, None] > idx[None, :]
    decay = jnp.exp(jnp.where(incl, gc[..., :, None] - gc[..., None, :], -jnp.inf))
    kb = kc * bc[..., None]
    lower = jnp.where(strict, jnp.einsum('nbhik,nbhjk->nbhij', kb, kc) * decay, 0.0)
    eye = jnp.eye(C, dtype=f32)
    rhs = jnp.concatenate([vc * bc[..., None], kb * jnp.exp(gc)[..., None]], axis=-1)
    sol = lax.linalg.triangular_solve(eye + lower, rhs, left_side=True, lower=True, unit_diagonal=True)
    u, w = sol[..., :DV], sol[..., DV:]
    intra = jnp.where(incl, jnp.einsum('nbhik,nbhjk->nbhij', qc, kc) * decay, 0.0)

    def step(S, inp):
        q_i, k_i, u_i, w_i, g_i, a_i = inp
        v_new = u_i - jnp.einsum('bhck,bhkv->bhcv', w_i, S)
        o_i = (jnp.einsum('bhck,bhkv->bhcv', q_i * jnp.exp(g_i)[..., None], S)
               + jnp.einsum('bhij,bhjv->bhiv', a_i, v_new))
        g_last = g_i[..., -1:]
        S = (S * jnp.exp(g_last)[..., None]
             + jnp.einsum('bhck,bhcv->bhkv', k_i * jnp.exp(g_last - g_i)[..., None], v_new))
        return S, o_i

    S, o = lax.scan(step, s0.astype(f32), (qc, kc, u, w, gc, intra))
    o = jnp.moveaxis(o, (0, 2), (1, 3)).reshape(B, T, H, DV)
    return o.astype(v.dtype), S


def _deltanet(q, k, v, z, a_f, a_b, b_f, b_b, a_log, dt_bias, norm_g, s0_f, s0_b):
    B, T, H, _ = q.shape
    qn = _l2norm(q) * (DN_DK ** -0.5)
    kn = _l2norm(k)
    f32 = jnp.float32
    g_f = -jnp.exp(a_log[0].astype(f32)) * jax.nn.softplus(a_f.astype(f32) + dt_bias[0].astype(f32))
    g_b = -jnp.exp(a_log[1].astype(f32)) * jax.nn.softplus(a_b.astype(f32) + dt_bias[1].astype(f32))
    beta_f = jax.nn.sigmoid(b_f.astype(f32))
    beta_b = jax.nn.sigmoid(b_b.astype(f32))
    o_f, s_f = _gdn_chunked(qn, kn, v, g_f, beta_f, s0_f)
    flip = lambda t: jnp.flip(t, axis=1)
    o_b, s_b = _gdn_chunked(flip(qn), flip(kn), flip(v), flip(g_b), flip(beta_b), s0_b)
    o = o_f + flip(o_b)
    o = _rms_norm(o, norm_g) * jax.nn.silu(z)
    return o.reshape(B, T, H * DN_DV), s_f, s_b


def _softmax_with_sink(s, sink):
    if sink is None:
        return jax.nn.softmax(s, axis=-1)
    sk = jnp.broadcast_to(sink.astype(jnp.float32)[:, :, None, None], s.shape[:-1] + (1,))
    return jax.nn.softmax(jnp.concatenate([s, sk], axis=-1), axis=-1)[..., :-1]


def _dense_attention(q, k, v, scale, sink):
    B, Tq, KH, G, D = q.shape
    nb = Tq // BLOCK
    qb = jnp.moveaxis(q.reshape(B, nb, BLOCK, KH, G, D), 1, 0)

    def one(q_i):
        s = jnp.einsum('bqkgd,btkd->bkgqt', q_i, k).astype(jnp.float32) * scale
        p = _softmax_with_sink(s, sink).astype(v.dtype)
        return jnp.einsum('bkgqt,btkv->bqkgv', p, v)

    o = lax.map(one, qb)
    return jnp.moveaxis(o, 0, 1).reshape(B, Tq, KH, G, v.shape[-1])


def _window_attention(q, k, v, k_ctx, v_ctx, sink, scale):
    B, T, KH, G, D = q.shape
    nb = T // BLOCK

    def band(a):
        ap = jnp.pad(a, ((0, 0), (BLOCK, BLOCK), (0, 0), (0, 0))).reshape(B, nb + 2, BLOCK, KH, a.shape[-1])
        return jnp.concatenate([ap[:, :nb], ap[:, 1:nb + 1], ap[:, 2:]], axis=2)

    qpos = jnp.arange(nb)[:, None, None] * BLOCK + jnp.arange(BLOCK)[None, :, None]
    kpos = (jnp.arange(nb)[:, None, None] - 1) * BLOCK + jnp.arange(3 * BLOCK)[None, None, :]
    valid = (jnp.abs(qpos - kpos) <= WINDOW) & (kpos >= 0) & (kpos < T)
    mv = lambda t: jnp.moveaxis(t, 1, 0)

    def one(args):
        q_i, k_i, v_i, m_i = args
        s_loc = jnp.einsum('bqkgd,btkd->bkgqt', q_i, k_i).astype(jnp.float32) * scale
        s_loc = jnp.where(m_i, s_loc, -jnp.inf)
        s_ctx = jnp.einsum('bqkgd,btkd->bkgqt', q_i, k_ctx).astype(jnp.float32) * scale
        p = _softmax_with_sink(jnp.concatenate([s_loc, s_ctx], axis=-1), sink).astype(v.dtype)
        return (jnp.einsum('bkgqt,btkv->bqkgv', p[..., :3 * BLOCK], v_i)
                + jnp.einsum('bkgqt,btkv->bqkgv', p[..., 3 * BLOCK:], v_ctx))

    o = lax.map(one, (mv(q.reshape(B, nb, BLOCK, KH, G, D)), mv(band(k)), mv(band(v)), valid))
    return jnp.moveaxis(o, 0, 1).reshape(B, T, KH, G, v.shape[-1])


def _mla_expand(ckv_n, w_ukv):
    B, T, _ = ckv_n.shape
    kv = (ckv_n @ w_ukv).reshape(B, T, MLA_HEADS, MLA_NOPE + MLA_V)
    return kv[..., :MLA_NOPE], kv[..., MLA_NOPE:]


def _trunk_layer(x, mod, lp, ctx):
    latent = ctx is not None
    B, T, _ = x.shape
    sh1, sc1, g1, sh2, sc2, g2 = jnp.split(mod, N_MOD, axis=-1)
    h = _rms_norm(x, lp['norm1_g']) * (1 + sc1) + sh1
    proj = h @ lp['w_in']
    offs = np.cumsum(IN_SPLITS)[:-1].tolist()
    (dn_qkv, dn_z, a_f, a_b, b_f, b_b, m_cq, m_ckv, m_kr, s_q, s_k, s_v) = jnp.split(proj, offs, axis=-1)

    qkv = _short_conv(dn_qkv, lp['dn_conv_w'])
    dq = qkv[..., :DN_HEADS * DN_DK].reshape(B, T, DN_HEADS, DN_DK)
    dk = qkv[..., DN_HEADS * DN_DK:2 * DN_HEADS * DN_DK].reshape(B, T, DN_HEADS, DN_DK)
    dv = qkv[..., 2 * DN_HEADS * DN_DK:].reshape(B, T, DN_HEADS, DN_DV)
    if latent:
        s0_f, s0_b = ctx['dn_f'], ctx['dn_b']
    else:
        s0_f = jnp.zeros((B, DN_HEADS, DN_DK, DN_DV), jnp.float32)
        s0_b = s0_f
    o_a, s_f, s_b = _deltanet(dq, dk, dv, dn_z.reshape(B, T, DN_HEADS, DN_DV), a_f, a_b, b_f, b_b,
                              lp['dn_a_log'], lp['dn_dt_bias'], lp['dn_norm_g'], s0_f, s0_b)

    q_m = (_rms_norm(m_cq, lp['mla_q_norm_g']) @ lp['mla_w_uq']).reshape(B, T, MLA_HEADS, MLA_NOPE + MLA_ROPE)
    q_nope, q_rope = q_m[..., :MLA_NOPE], q_m[..., MLA_NOPE:]
    ckv_n = _rms_norm(m_ckv, lp['mla_kv_norm_g'])
    k_nope, v_m = _mla_expand(ckv_n, lp['mla_w_ukv'])
    k_rope = m_kr[:, :, None, :]
    if latent:
        cos_m, sin_m = _axial_rope_tables(T, MLA_ROPE)
        q_rope = _apply_rope(q_rope, cos_m, sin_m)
        k_rope = _apply_rope(k_rope, cos_m, sin_m)
    q_m = jnp.concatenate([q_nope, q_rope], axis=-1)
    k_m = jnp.concatenate([k_nope, jnp.broadcast_to(k_rope, (B, T, MLA_HEADS, MLA_ROPE))], axis=-1)
    if latent:
        P = ctx['mla_ckv'].shape[1]
        kn_c, v_c = _mla_expand(ctx['mla_ckv'], lp['mla_w_ukv'])
        kr_c = jnp.broadcast_to(ctx['mla_krope'][:, :, None, :], (B, P, MLA_HEADS, MLA_ROPE))
        k_m = jnp.concatenate([jnp.concatenate([kn_c, kr_c], axis=-1), k_m], axis=1)
        v_m = jnp.concatenate([v_c, v_m], axis=1)
    o_b = _dense_attention(q_m[:, :, :, None, :], k_m, v_m, MLA_SCALE, None)

    q_c = s_q.reshape(B, T, SWA_HEADS, SWA_HD)
    k_c = s_k.reshape(B, T, SWA_KV_HEADS, SWA_HD)
    v_c = s_v.reshape(B, T, SWA_KV_HEADS, SWA_HD)
    sink = lp['swa_sink'].reshape(SWA_KV_HEADS, SWA_HEADS // SWA_KV_HEADS)
    if latent:
        cos_s, sin_s = _axial_rope_tables(T, SWA_HD)
        q_r = _apply_rope(q_c, cos_s, sin_s).reshape(B, T, SWA_KV_HEADS, SWA_HEADS // SWA_KV_HEADS, SWA_HD)
        k_r = _apply_rope(k_c, cos_s, sin_s)
        o_c = _window_attention(q_r, k_r, v_c, ctx['swa_k'], ctx['swa_v'], sink, SWA_SCALE)
    else:
        q_g = q_c.reshape(B, T, SWA_KV_HEADS, SWA_HEADS // SWA_KV_HEADS, SWA_HD)
        o_c = _dense_attention(q_g, k_c, v_c, SWA_SCALE, sink)

    mix = jnp.concatenate([o_a, o_b.reshape(B, T, -1), o_c.reshape(B, T, -1)], axis=-1) @ lp['w_out']
    x = x + g1 * mix

    h2 = _rms_norm(x, lp['norm2_g']) * (1 + sc2) + sh2
    x = x + g2 * (jnp.square(jax.nn.relu(h2 @ lp['w_ff1'])) @ lp['w_ff2'])
    if latent:
        return x, None
    return x, (jnp.stack([s_f, s_b], axis=1), ckv_n, m_kr, k_c, v_c)


def setup_inputs(seed: int = 0) -> dict:
    key = jax.random.key(seed)
    ks = jax.random.split(key, 32)
    f32 = jnp.float32
    nrm = lambda k, shape, s: jax.random.normal(k, shape, f32) * s
    gain = lambda k, shape: 1.0 + 0.05 * jax.random.normal(k, shape, f32)
    L = DEPTH
    dt = jnp.exp(jax.random.uniform(ks[14], (L, 2, DN_HEADS), f32, math.log(1e-3), math.log(1e-1)))
    return {
        'x_prompt': nrm(ks[0], (BATCH, SEQ, D_MODEL), 1.0),
        'x_sample': nrm(ks[1], (DEC_BATCH, DEC_SEQ, D_MODEL), 1.0),
        'state_dn': nrm(ks[2], (DEC_BATCH, L, 2, DN_HEADS, DN_DK, DN_DV), 0.1),
        'cache_mla_ckv': nrm(ks[3], (DEC_BATCH, L, PAST_LEN, MLA_KV_LORA), 1.0),
        'cache_mla_krope': nrm(ks[4], (DEC_BATCH, L, PAST_LEN, MLA_ROPE), 1.0),
        'cache_swa_k': nrm(ks[5], (DEC_BATCH, L, PAST_LEN, SWA_KV_HEADS, SWA_HD), 1.0),
        'cache_swa_v': nrm(ks[6], (DEC_BATCH, L, PAST_LEN, SWA_KV_HEADS, SWA_HD), 1.0),
        'c': nrm(ks[7], (DEC_BATCH, D_MODEL), 1.0),
        'c_ctx': nrm(ks[8], (D_MODEL,), 1.0),
        'ada_w': nrm(ks[9], (L, D_MODEL, N_MOD * D_MODEL), 0.5 * D_MODEL ** -0.5),
        'ada_b': nrm(ks[10], (L, N_MOD * D_MODEL), 0.02),
        'norm1_g': gain(ks[11], (L, D_MODEL)),
        'norm2_g': gain(ks[12], (L, D_MODEL)),
        'w_in': nrm(ks[13], (L, D_MODEL, IN_W), D_MODEL ** -0.5),
        'dn_conv_w': nrm(ks[15], (L, DN_CONV, DN_CONV_CH), DN_CONV ** -0.5),
        'dn_a_log': jnp.log(jax.random.uniform(ks[16], (L, 2, DN_HEADS), f32, 1.0, 16.0)),
        'dn_dt_bias': dt + jnp.log(-jnp.expm1(-dt)),
        'dn_norm_g': gain(ks[17], (L, DN_DV)),
        'mla_q_norm_g': gain(ks[18], (L, MLA_Q_LORA)),
        'mla_w_uq': nrm(ks[19], (L, MLA_Q_LORA, MLA_HEADS * (MLA_NOPE + MLA_ROPE)), MLA_Q_LORA ** -0.5),
        'mla_kv_norm_g': gain(ks[20], (L, MLA_KV_LORA)),
        'mla_w_ukv': nrm(ks[21], (L, MLA_KV_LORA, MLA_HEADS * (MLA_NOPE + MLA_V)), MLA_KV_LORA ** -0.5),
        'swa_sink': nrm(ks[22], (L, SWA_HEADS), 0.5),
        'w_out': nrm(ks[23], (L, MIX_W, D_MODEL), MIX_W ** -0.5),
        'w_ff1': nrm(ks[24], (L, D_MODEL, D_FF), D_MODEL ** -0.5),
        'w_ff2': nrm(ks[25], (L, D_FF, D_MODEL), D_FF ** -0.5),
        'final_norm_g': gain(ks[26], (D_MODEL,)),
    }


def reference(x_prompt, x_sample, state_dn, cache_mla_ckv, cache_mla_krope, cache_swa_k, cache_swa_v,
              c, c_ctx, ada_w, ada_b, norm1_g, norm2_g, w_in, dn_conv_w, dn_a_log, dn_dt_bias, dn_norm_g,
              mla_q_norm_g, mla_w_uq, mla_kv_norm_g, mla_w_ukv, swa_sink, w_out, w_ff1, w_ff2, final_norm_g):
    layers = [dict(norm1_g=norm1_g[l], norm2_g=norm2_g[l], w_in=w_in[l], dn_conv_w=dn_conv_w[l],
                   dn_a_log=dn_a_log[l], dn_dt_bias=dn_dt_bias[l], dn_norm_g=dn_norm_g[l],
                   mla_q_norm_g=mla_q_norm_g[l], mla_w_uq=mla_w_uq[l], mla_kv_norm_g=mla_kv_norm_g[l],
                   mla_w_ukv=mla_w_ukv[l], swa_sink=swa_sink[l], w_out=w_out[l],
                   w_ff1=w_ff1[l], w_ff2=w_ff2[l]) for l in range(DEPTH)]

    xp = x_prompt
    new_dn, new_ckv, new_kr, new_k, new_v = [], [], [], [], []
    for l in range(DEPTH):
        mod_ctx = jax.nn.silu(c_ctx) @ ada_w[l] + ada_b[l]
        xp, (s_dn, ckv_n, kr, k_c, v_c) = _trunk_layer(xp, mod_ctx, layers[l], None)
        new_dn.append(s_dn)
        new_ckv.append(ckv_n)
        new_kr.append(kr)
        new_k.append(k_c)
        new_v.append(v_c)
    y_prompt = _rms_norm(xp, final_norm_g)

    xs = x_sample
    for l in range(DEPTH):
        mod = (jax.nn.silu(c) @ ada_w[l] + ada_b[l])[:, None, :]
        ctx = dict(dn_f=state_dn[:, l, 0], dn_b=state_dn[:, l, 1], mla_ckv=cache_mla_ckv[:, l],
                   mla_krope=cache_mla_krope[:, l], swa_k=cache_swa_k[:, l], swa_v=cache_swa_v[:, l])
        xs, _ = _trunk_layer(xs, mod, layers[l], ctx)
    y_sample = _rms_norm(xs, final_norm_g)

    return (y_prompt, y_sample, jnp.stack(new_dn, axis=1), jnp.stack(new_ckv, axis=1),
            jnp.stack(new_kr, axis=1), jnp.stack(new_k, axis=1), jnp.stack(new_v, axis=1))
```

```cpp
#include <hip/hip_runtime.h>
#define PHMASK 0xffff
#define MIXMASK 15
#define DBG_NOA 0
#define PROBE_SEL 0
#include <hip/hip_cooperative_groups.h>
#include <cstdio>
#include <cstdint>
namespace cg = cooperative_groups;

#define LAS __attribute__((address_space(3)))
typedef unsigned short bf16_t;
typedef short bf16x8 __attribute__((ext_vector_type(8)));
typedef float f32x4 __attribute__((ext_vector_type(4)));
typedef float f32x2 __attribute__((ext_vector_type(2)));
typedef unsigned u32x4 __attribute__((ext_vector_type(4)));
typedef unsigned u32x2 __attribute__((ext_vector_type(2)));

constexpr int D = 1024, MP = 8192, MS = 32768, M = MP + MS, NP = 3072, FF = 4096;
constexpr int C_DQ = 0, C_MCQ = 512, C_SQ = 768, C_DK = 1024, C_DV = 1536, C_DZ = 2048, C_AB = 2560, C_MCKV = 2576, C_MKR = 2704, C_SK = 2736, C_SV = 2864;
constexpr int KVROWS = 8192 + 8 * 4352;
constexpr float LOG2E = 1.4426950408889634f;
constexpr float EPS = 1e-6f;

constexpr size_t MiB = 1u << 20;
constexpr size_t WS_CTL = 0;
constexpr size_t WS_MODV = 1 * MiB;
constexpr size_t WS_GB = 2 * MiB;
constexpr size_t WS_GC = 5 * MiB;
constexpr size_t WS_SWACK = 7 * MiB;
constexpr size_t WS_SWACV = 7 * MiB + 512 * 1024;
constexpr size_t WS_W = 8 * MiB;
constexpr size_t WS_WIN = WS_W;
constexpr size_t WS_WOUT = WS_WIN + 12 * MiB;
constexpr size_t WS_WFF1 = WS_WOUT + 4 * MiB;
constexpr size_t WS_WFF2 = WS_WFF1 + 16 * MiB;
constexpr size_t WS_WUQ = WS_WFF2 + 16 * MiB;
constexpr size_t WS_WUKV = WS_WUQ + 512 * 1024;
constexpr size_t WS_H = 57 * MiB;
constexpr size_t WS_BIG = 137 * MiB;
constexpr size_t WS_DNV = WS_BIG + 240 * MiB;
constexpr size_t WS_MLAQ = WS_DNV + 40 * MiB;
constexpr size_t WS_MLAKN = 457 * MiB;
constexpr size_t WS_MLAV = 478 * MiB;
constexpr size_t WS_MLAKR = 499 * MiB;
constexpr size_t WS_ROPEM = 502 * MiB;
constexpr size_t WS_ROPES = 502 * MiB + 512 * 1024;
constexpr size_t WS_HALO = 504 * MiB;
constexpr size_t WS_END = 508 * MiB;

constexpr size_t O_STATE = (size_t)M * D;
constexpr size_t O_CKV = O_STATE + 8388608;
constexpr size_t O_KR = O_CKV + 2097152;
constexpr size_t O_SK = O_KR + 524288;
constexpr size_t O_SV = O_SK + 2097152;

constexpr int LDS_BYTES = 147456;

struct Params { const float* in[27]; float* out; unsigned char* ws; };

typedef float f32x2_t __attribute__((ext_vector_type(2))); typedef __bf16 bf16x2_t __attribute__((ext_vector_type(2)));
__device__ __forceinline__ unsigned cvt_pk_bf16(float lo, float hi) { f32x2_t v = {lo, hi}; bf16x2_t b = __builtin_convertvector(v, bf16x2_t); return __builtin_bit_cast(unsigned, b); }
__device__ __forceinline__ unsigned short f2bf(float f) { return (unsigned short)(cvt_pk_bf16(f, 0.f) & 0xffffu); }
__device__ __forceinline__ float bf2f(unsigned short h) { return __uint_as_float((unsigned)h << 16); }
__device__ __forceinline__ float bflo(unsigned u) { return __uint_as_float(u << 16); }
__device__ __forceinline__ float bfhi(unsigned u) { return __uint_as_float(u & 0xffff0000u); }
__device__ __forceinline__ bf16x8 pack8(f32x4 a, f32x4 b) {
    u32x4 w; w.x = cvt_pk_bf16(a[0], a[1]); w.y = cvt_pk_bf16(a[2], a[3]); w.z = cvt_pk_bf16(b[0], b[1]); w.w = cvt_pk_bf16(b[2], b[3]);
    return __builtin_bit_cast(bf16x8, w);
}
__device__ __forceinline__ bf16x8 ld2x4(const bf16_t* p0, const bf16_t* p1) {
    u32x2 a = *(const u32x2*)p0, b = *(const u32x2*)p1; u32x4 w; w.x = a.x; w.y = a.y; w.z = b.x; w.w = b.y; return __builtin_bit_cast(bf16x8, w);
}
typedef short v4i16_t __attribute__((ext_vector_type(4)));
__device__ __forceinline__ u32x2 ld_tr4(const bf16_t* p) { return __builtin_bit_cast(u32x2, __builtin_amdgcn_ds_read_tr16_b64_v4i16((LAS v4i16_t*)p)); }
__device__ __forceinline__ bf16x8 ld8(const bf16_t* p) { return __builtin_bit_cast(bf16x8, *(const u32x4*)p); }
__device__ __forceinline__ f32x4 mfma16(bf16x8 a, bf16x8 b, f32x4 c) { return __builtin_amdgcn_mfma_f32_16x16x32_bf16(a, b, c, 0, 0, 0); }
__device__ __forceinline__ float wave_sum(float v) {
#pragma unroll
    for (int o = 1; o < 64; o <<= 1) v += __shfl_xor(v, o);
    return v;
}
__device__ __forceinline__ float fexp(float x) { return __builtin_amdgcn_exp2f(x * LOG2E); }
__device__ __forceinline__ float silu(float x) { return x / (1.f + fexp(-x)); }
__device__ __forceinline__ int win_dst(int n) {
    if (n < 512) return C_DQ + n;
    if (n < 1024) return C_DK + (n - 512);
    if (n < 1536) return C_DV + (n - 1024);
    if (n < 2048) return C_DZ + (n - 1536);
    if (n < 2064) return C_AB + (n - 2048);
    if (n < 2320) return C_MCQ + (n - 2064);
    if (n < 2448) return C_MCKV + (n - 2320);
    if (n < 2480) return C_MKR + (n - 2448);
    if (n < 2736) return C_SQ + (n - 2480);
    return n;
}
#define LDS_WAIT() asm volatile("s_waitcnt lgkmcnt(0)" ::: "memory")
__device__ __forceinline__ void probe_max(unsigned char* ws, int slot, float v) { if (v == v) atomicMax((int*)(ws + 2048) + slot, __float_as_int(fabsf(v))); else atomicMax((int*)(ws + 2048) + slot, 0x7f000000); }
__device__ __forceinline__ int opaque(int x) { asm volatile("" : "+v"(x)); return x; }
#define LOCAL_LANES const int tid = opaque(tid0), lane = tid & 63, fr = lane & 15, fq = lane >> 4; (void)fr; (void)fq; (void)lane

namespace pg8 {
constexpr int BM = 256, BK = 64, HALF = 128, HTB = HALF * BK * 2, STAGE_BYTES = 8 * HTB, NXCD = 8, WGM = 8;
__host__ __device__ __forceinline__ int lds_byte(int r, int c) { const int st = (r >> 4) * 2 + (c >> 5), rr = r & 15, cc = c & 31, ob = rr * 64 + cc * 2; return st * 1024 + (ob ^ (((ob >> 9) & 1) << 5)); }
__host__ __device__ __forceinline__ void stage_rc(int b, int& R, int& C) { const int st = b / 1024, sb = b % 1024, swz = sb ^ (((sb >> 9) & 1) << 5); R = (st >> 1) * 16 + swz / 64; C = (st & 1) * 32 + (swz % 64) / 2; }
__host__ __device__ __forceinline__ int perm32(int rho) { const int n = rho >> 4, i = rho & 15; return 8 * (i >> 2) + 4 * n + (i & 3); }
struct Unit { int pm, pn; };
struct Gemm { const bf16_t* A; const bf16_t* Bt; int M, N, K, lda; };
struct StaticOrder {
    int nM, nN, nwg, G, c;
    __device__ void init(int M_, int N_, int G_, int c_) { nM = M_ / BM; nN = N_ / BM; nwg = nM * nN; G = G_; c = c_; }
    __device__ bool next(int i, Unit& u) const {
        const long L = (long)i * G + c; if (L >= nwg) return false;
        int wgid = (int)L; { const int q = nwg / NXCD, r = nwg % NXCD, xcd = wgid % NXCD, off = wgid / NXCD; wgid = (xcd < r ? xcd * (q + 1) : r * (q + 1) + (xcd - r) * q) + off; }
        const int nig = WGM * nN, gid = wgid / nig, fm = gid * WGM, gsz = (nM - fm) < WGM ? (nM - fm) : WGM;
        u.pm = fm + ((wgid % nig) % gsz); u.pn = (wgid % nig) / gsz; return true;
    }
};

template <class Epi, bool ALIGN_EPI, bool SP2>
__device__ __forceinline__ void gemm_phase(LAS unsigned char* lds, const Gemm g, const StaticOrder& S, const Epi& E) {
    const int tid = opaque(threadIdx.x), wid = __builtin_amdgcn_readfirstlane(tid >> 6), lane = tid & 63, wr = wid >> 2, wc = wid & 3, fr = lane & 15, fq = lane >> 4;
    const int K = g.K, nt = K / BK, lda = g.lda;
    unsigned voffA[2], voffB[2];
#pragma unroll
    for (int i = 0; i < 2; ++i) { int R, C; stage_rc(tid * 16 + i * 8192, R, C); const int Rb = Epi::PERM ? ((R & ~31) + perm32(R & 31)) : R;
        voffA[i] = (unsigned)(R * lda + C) * 2u; voffB[i] = (unsigned)(Rb * K + C) * 2u; }
    const size_t kstep = (size_t)(BK * 2);
    const size_t hstepA = (size_t)HALF * lda * 2, hstepB = (size_t)HALF * K * 2;
    const size_t tstepA = 2 * hstepA, tstepB = 2 * hstepB;
    const unsigned ldsw = (unsigned)wid * 1024u;
    const int aoff = lds_byte(wr * 64 + fr, fq * 8), boff = lds_byte(wc * 32 + fr, fq * 8);
#define PG8_SA(b, h) (((b) * 2 + (h)) * HTB)
#define PG8_SB(b, h) ((4 + (b) * 2 + (h)) * HTB)
#define PG8_STAGE(bufoff, gbase, voff) do { _Pragma("unroll") for (int _i = 0; _i < 2; ++_i) \
        __builtin_amdgcn_global_load_lds((const unsigned*)((const char*)(gbase) + (voff)[_i]), (LAS unsigned*)(lds + (bufoff) + ldsw + _i * 8192), 16, 0, 0); } while (0)
#define PG8_LDA(dst, b, h) do { _Pragma("unroll") for (int m = 0; m < 4; ++m) _Pragma("unroll") for (int k = 0; k < 2; ++k) dst[m][k] = *(const LAS bf16x8*)(lds + PG8_SA(b, h) + aoff + m * 2048 + k * 1024); } while (0)
#define PG8_LDB(dst, b, h) do { _Pragma("unroll") for (int n = 0; n < 2; ++n) _Pragma("unroll") for (int k = 0; k < 2; ++k) dst[n][k] = *(const LAS bf16x8*)(lds + PG8_SB(b, h) + boff + n * 2048 + k * 1024); } while (0)
#define PG8_MMA(ai, bj, At, Bt) do { __builtin_amdgcn_s_setprio(1); _Pragma("unroll") for (int m = 0; m < 4; ++m) _Pragma("unroll") for (int n = 0; n < 2; ++n) _Pragma("unroll") for (int k = 0; k < 2; ++k) \
        acc[ai][bj][m][n] = __builtin_amdgcn_mfma_f32_16x16x32_bf16(Bt[n][k], At[m][k], acc[ai][bj][m][n], 0, 0, 0); __builtin_amdgcn_s_setprio(0); } while (0)
#define PG8_WAIT_V(n) asm volatile("s_waitcnt vmcnt(" #n ")" ::: "memory")
#define PG8_WAIT_L(n) asm volatile("s_waitcnt lgkmcnt(" #n ")" ::: "memory")
#define PG8_BAR __builtin_amdgcn_s_barrier()
#define PG8_SCHED __builtin_amdgcn_sched_barrier(0)
    Unit cur, nxt; int ui = 0;
    if (!S.next(0, cur)) return;
    f32x4 acc[2][2][4][2];
#pragma unroll
    for (int a = 0; a < 2; ++a)
#pragma unroll
        for (int b = 0; b < 2; ++b)
#pragma unroll
            for (int m = 0; m < 4; ++m)
#pragma unroll
                for (int n = 0; n < 2; ++n) acc[a][b][m][n] = (f32x4){0.f, 0.f, 0.f, 0.f};
    bf16x8 At[4][2], B0[2][2], B1[2][2];
    const char* cA = (const char*)g.A + (size_t)cur.pm * tstepA; const char* cB = (const char*)g.Bt + (size_t)cur.pn * tstepB;
    if constexpr (SP2) {
        PG8_STAGE(PG8_SB(0, 0), cB, voffB); PG8_STAGE(PG8_SB(0, 1), cB + hstepB, voffB); PG8_STAGE(PG8_SA(0, 0), cA, voffA); PG8_STAGE(PG8_SA(0, 1), cA + hstepA, voffA);
        if (wr == 1) PG8_BAR;
        PG8_WAIT_V(2); PG8_BAR;
        PG8_STAGE(PG8_SB(1, 0), cB + kstep, voffB); PG8_STAGE(PG8_SA(1, 0), cA + kstep, voffA); PG8_STAGE(PG8_SB(1, 1), cB + hstepB + kstep, voffB);
        PG8_WAIT_V(6); PG8_BAR;
    } else {
        PG8_STAGE(PG8_SB(0, 0), cB, voffB); PG8_STAGE(PG8_SA(0, 0), cA, voffA); PG8_STAGE(PG8_SB(0, 1), cB + hstepB, voffB); PG8_STAGE(PG8_SA(0, 1), cA + hstepA, voffA);
        if (wr == 1) PG8_BAR;
        PG8_WAIT_V(4); PG8_BAR;
        PG8_STAGE(PG8_SB(1, 0), cB + kstep, voffB); PG8_STAGE(PG8_SA(1, 0), cA + kstep, voffA); PG8_STAGE(PG8_SB(1, 1), cB + hstepB + kstep, voffB);
        PG8_WAIT_V(6); PG8_BAR;
    }
    for (;;) {
        const bool has_next = S.next(ui + 1, nxt);
        const char* nA = has_next ? (const char*)g.A + (size_t)nxt.pm * tstepA : cA; const char* nB = has_next ? (const char*)g.Bt + (size_t)nxt.pn * tstepB : cB;
        for (int t = 0; t < nt; t += 2) {
            const bool last = (t == nt - 2);
            const char* a1 = cA + (size_t)(t + 1) * kstep;
            const char* a2 = last ? nA : cA + (size_t)(t + 2) * kstep; const char* b2 = last ? nB : cB + (size_t)(t + 2) * kstep;
            const char* a3 = a2 + kstep; const char* b3 = b2 + kstep;
            if constexpr (SP2) {
            PG8_LDB(B0, 0, 0); PG8_LDB(B1, 0, 1); PG8_SCHED; PG8_LDA(At, 0, 0); PG8_STAGE(PG8_SA(1, 1), a1 + hstepA, voffA);
            PG8_WAIT_V(8); PG8_WAIT_L(0); PG8_BAR; PG8_MMA(0, 0, At, B0); PG8_MMA(0, 1, At, B1); PG8_BAR; PG8_SCHED;
            PG8_LDA(At, 0, 1); PG8_STAGE(PG8_SB(0, 0), b2, voffB); PG8_STAGE(PG8_SB(0, 1), b2 + hstepB, voffB); PG8_STAGE(PG8_SA(0, 0), a2, voffA);
            PG8_WAIT_V(8); PG8_WAIT_L(0); PG8_BAR; PG8_MMA(1, 0, At, B0); PG8_MMA(1, 1, At, B1); PG8_BAR; PG8_SCHED;
            PG8_LDB(B0, 1, 0); PG8_LDB(B1, 1, 1); PG8_SCHED; PG8_LDA(At, 1, 0); PG8_STAGE(PG8_SA(0, 1), a2 + hstepA, voffA);
            PG8_WAIT_V(8); PG8_WAIT_L(0); PG8_BAR; PG8_MMA(0, 0, At, B0); PG8_MMA(0, 1, At, B1); PG8_BAR; PG8_SCHED;
            PG8_LDA(At, 1, 1); PG8_STAGE(PG8_SB(1, 0), b3, voffB); PG8_STAGE(PG8_SB(1, 1), b3 + hstepB, voffB); PG8_STAGE(PG8_SA(1, 0), a3, voffA);
            PG8_WAIT_V(8); PG8_WAIT_L(0); PG8_BAR; PG8_MMA(1, 0, At, B0); PG8_MMA(1, 1, At, B1); PG8_BAR; PG8_SCHED;
            } else {
            PG8_LDB(B0, 0, 0); PG8_SCHED; PG8_LDA(At, 0, 0); PG8_STAGE(PG8_SA(1, 1), a1 + hstepA, voffA);
            PG8_WAIT_L(8); PG8_BAR; PG8_WAIT_L(0); PG8_MMA(0, 0, At, B0); PG8_BAR; PG8_SCHED;
            PG8_LDB(B1, 0, 1); PG8_STAGE(PG8_SB(0, 0), b2, voffB);
            PG8_BAR; PG8_WAIT_L(0); PG8_MMA(0, 1, At, B1); PG8_BAR;
            PG8_LDA(At, 0, 1); PG8_STAGE(PG8_SA(0, 0), a2, voffA);
            PG8_BAR; PG8_WAIT_L(0); PG8_MMA(1, 0, At, B0); PG8_BAR; PG8_SCHED;
            PG8_STAGE(PG8_SB(0, 1), b2 + hstepB, voffB);
            PG8_WAIT_V(6); PG8_BAR; PG8_MMA(1, 1, At, B1); PG8_BAR;
            PG8_LDB(B0, 1, 0); PG8_SCHED; PG8_LDA(At, 1, 0); PG8_STAGE(PG8_SA(0, 1), a2 + hstepA, voffA);
            PG8_WAIT_L(8); PG8_BAR; PG8_WAIT_L(0); PG8_MMA(0, 0, At, B0); PG8_BAR; PG8_SCHED;
            PG8_LDB(B1, 1, 1); PG8_STAGE(PG8_SB(1, 0), b3, voffB);
            PG8_BAR; PG8_WAIT_L(0); PG8_MMA(0, 1, At, B1); PG8_BAR;
            PG8_LDA(At, 1, 1); PG8_STAGE(PG8_SA(1, 0), a3, voffA);
            PG8_BAR; PG8_WAIT_L(0); PG8_MMA(1, 0, At, B0); PG8_BAR; PG8_SCHED;
            PG8_STAGE(PG8_SB(1, 1), b3 + hstepB, voffB);
            PG8_WAIT_V(6); PG8_BAR; PG8_MMA(1, 1, At, B1); PG8_BAR;
            }
        }
        if constexpr (ALIGN_EPI) { if (wr == 0) PG8_BAR; }
        E(acc, cur, wr, wc, fr, fq);
        if (!has_next) break;
#pragma unroll
        for (int a = 0; a < 2; ++a)
#pragma unroll
            for (int b = 0; b < 2; ++b)
#pragma unroll
                for (int m = 0; m < 4; ++m)
#pragma unroll
                    for (int n = 0; n < 2; ++n) acc[a][b][m][n] = (f32x4){0.f, 0.f, 0.f, 0.f};
        cur = nxt; cA = nA; cB = nB; ++ui;
        if constexpr (ALIGN_EPI) { if (wr == 1) PG8_BAR; }
    }
    PG8_WAIT_V(0);
    if constexpr (!ALIGN_EPI) { if (wr == 0) PG8_BAR; }
    PG8_BAR;
#undef PG8_SA
#undef PG8_SB
#undef PG8_STAGE
#undef PG8_LDA
#undef PG8_LDB
#undef PG8_MMA
#undef PG8_WAIT_V
#undef PG8_WAIT_L
#undef PG8_BAR
#undef PG8_SCHED
}

struct EpiProj {
    static constexpr bool PERM = true;
    bf16_t* O; bf16_t* halo; float* out_kr; float* out_sk; float* out_sv; int l;
    __device__ __forceinline__ void operator()(const f32x4 (&acc)[2][2][4][2], const Unit& u, int wr, int wc, int fr, int fq) const {
        const int row0 = u.pm * BM + wr * 64 + fr; const int col0 = u.pn * BM + wc * 32 + 8 * fq;
#pragma unroll
        for (int ai = 0; ai < 2; ++ai)
#pragma unroll
            for (int m = 0; m < 4; ++m) {
                const int row = row0 + ai * HALF + m * 16;
#pragma unroll
                for (int bj = 0; bj < 2; ++bj) {
                    const int col = col0 + bj * HALF;
                    const f32x4 v0 = acc[ai][bj][m][0], v1 = acc[ai][bj][m][1];
                    u32x4 w; w.x = cvt_pk_bf16(v0[0], v0[1]); w.y = cvt_pk_bf16(v0[2], v0[3]); w.z = cvt_pk_bf16(v1[0], v1[1]); w.w = cvt_pk_bf16(v1[2], v1[3]);
                    *(u32x4*)(O + (size_t)row * NP + col) = w;
                    if (u.pn >= 10 && row < MP && col >= C_MKR && col < 2992) {
                        const int b = row >> 8, t = row & 255; const size_t tok = (size_t)(b * 2 + l) * 256 + t;
                        float* dst = (col < C_SK) ? out_kr + tok * 32 + (col - C_MKR) : (col < C_SV) ? out_sk + tok * 128 + (col - C_SK) : out_sv + tok * 128 + (col - C_SV);
                        *(f32x4*)dst = v0; *(f32x4*)(dst + 4) = v1;
                    }
                    const int r63 = row & 63;
                    if ((r63 == 0 || r63 == 63) && (col < 512 || (col >= 1024 && col < 2048))) {
                        const int hc = col < 512 ? col : col - 512;
                        *(u32x4*)(halo + (size_t)((row >> 6) * 2 + (r63 == 63)) * 1536 + hc) = w;
                    }
                }
            }
    }
};
struct EpiRelu2 {
    static constexpr bool PERM = true;
    bf16_t* O;
    __device__ __forceinline__ void operator()(const f32x4 (&acc)[2][2][4][2], const Unit& u, int wr, int wc, int fr, int fq) const {
        const int row0 = u.pm * BM + wr * 64 + fr; const int col0 = u.pn * BM + wc * 32 + 8 * fq;
#pragma unroll
        for (int ai = 0; ai < 2; ++ai)
#pragma unroll
            for (int m = 0; m < 4; ++m) {
                bf16_t* rowp = O + (size_t)(row0 + ai * HALF + m * 16) * FF + col0;
#pragma unroll
                for (int bj = 0; bj < 2; ++bj) {
                    f32x4 v0 = acc[ai][bj][m][0], v1 = acc[ai][bj][m][1];
#pragma unroll
                    for (int e = 0; e < 4; ++e) { float a = fmaxf(v0[e], 0.f); v0[e] = a * a; float b = fmaxf(v1[e], 0.f); v1[e] = b * b; }
                    u32x4 w; w.x = cvt_pk_bf16(v0[0], v0[1]); w.y = cvt_pk_bf16(v0[2], v0[3]); w.z = cvt_pk_bf16(v1[0], v1[1]); w.w = cvt_pk_bf16(v1[2], v1[3]);
                    *(u32x4*)(rowp + bj * HALF) = w;
                }
            }
    }
};
struct EpiResid {
    static constexpr bool PERM = false;
    float* X; const float* gate; const float* basep; const float* bases;
    __device__ __forceinline__ void operator()(const f32x4 (&acc)[2][2][4][2], const Unit& u, int wr, int wc, int fr, int fq) const {
        const int rowt = u.pm * BM; const int bi = rowt < MP ? 0 : 1 + ((rowt - MP) >> 12);
        const float* gp = gate + (size_t)bi * 6144;
        const int col0 = u.pn * BM + wc * 32 + 4 * fq;
        f32x4 gv[2][2];
#pragma unroll
        for (int bj = 0; bj < 2; ++bj)
#pragma unroll
            for (int n = 0; n < 2; ++n) gv[bj][n] = *(const f32x4*)(gp + col0 + bj * HALF + n * 16);
#pragma unroll
        for (int ai = 0; ai < 2; ++ai)
#pragma unroll
            for (int m = 0; m < 4; ++m) {
                const size_t roff = (size_t)(rowt + ai * HALF + wr * 64 + m * 16 + fr) * D + col0;
                float* rowp = X + roff; const float* srcp = basep ? (rowt < MP ? basep + roff : bases + (roff - (size_t)MP * D)) : rowp;
#pragma unroll
                for (int bj = 0; bj < 2; ++bj)
#pragma unroll
                    for (int n = 0; n < 2; ++n) { f32x4* xp = (f32x4*)(rowp + bj * HALF + n * 16); f32x4 x = *(const f32x4*)(srcp + bj * HALF + n * 16); x = x + gv[bj][n] * acc[ai][bj][m][n]; *xp = x; }
            }
    }
};
}

template <bool WIN>
__device__ __forceinline__ void transpose_item(const float* W, int K, int Nsrc, bf16_t* WT, float* scr, int kb, int nb, int lane) {
    const int k0 = 64 * kb, n0 = 32 * nb;
    float tmp[32];
#pragma unroll
    for (int i = 0; i < 32; ++i) { const int kk = 2 * i + (lane >> 5); const int n = n0 + (lane & 31); tmp[i] = (n < Nsrc) ? W[(size_t)(k0 + kk) * Nsrc + n] : 0.f; }
#pragma unroll
    for (int i = 0; i < 32; ++i) { const int kk = 2 * i + (lane >> 5); scr[kk * 33 + (lane & 31)] = tmp[i]; }
    LDS_WAIT();
    const int c = lane & 7;
#pragma unroll
    for (int j = 0; j < 4; ++j) { const int n = (lane >> 3) + 8 * j; const float* s = scr + (8 * c) * 33 + n;
        u32x4 o; o.x = cvt_pk_bf16(s[0 * 33], s[1 * 33]); o.y = cvt_pk_bf16(s[2 * 33], s[3 * 33]); o.z = cvt_pk_bf16(s[4 * 33], s[5 * 33]); o.w = cvt_pk_bf16(s[6 * 33], s[7 * 33]);
        const int dn = WIN ? win_dst(n0 + n) : (n0 + n);
        *(u32x4*)(WT + (size_t)dn * K + k0 + 8 * c) = o; }
    LDS_WAIT();
}

__device__ __forceinline__ void phase0(const Params& P, unsigned char* smem) {
    const int tid = opaque(threadIdx.x), lane = tid & 63, wave = tid >> 6;
    unsigned char* ws = P.ws;
    if (blockIdx.x < 192) {
        float* sv = (float*)smem;
        float* red = sv + 9 * 1024;
        const int l = blockIdx.x / 96, cb = blockIdx.x % 96;
        for (int i = tid; i < 9 * 1024; i += 512) { const int v = i >> 10, k = i & 1023; const float x = (v == 0) ? P.in[8][k] : P.in[7][(v - 1) * 1024 + k]; sv[i] = silu(x); }
        __syncthreads();
        const float* aw = P.in[9] + (size_t)l * 1024 * 6144 + cb * 64 + lane;
        float acc[9];
#pragma unroll
        for (int i = 0; i < 9; ++i) acc[i] = 0.f;
        const int kb = wave * 128;
#pragma unroll 16
        for (int k = 0; k < 128; ++k) { const float a = aw[(size_t)(kb + k) * 6144];
#pragma unroll
            for (int i = 0; i < 9; ++i) acc[i] += sv[i * 1024 + kb + k] * a; }
#pragma unroll
        for (int i = 0; i < 9; ++i) red[(wave * 9 + i) * 64 + lane] = acc[i];
        __syncthreads();
        for (int o = tid; o < 9 * 64; o += 512) { const int i = o >> 6, c = o & 63; float s = P.in[10][l * 6144 + cb * 64 + c];
#pragma unroll
            for (int w = 0; w < 8; ++w) s += red[(w * 9 + i) * 64 + c];
            ((float*)(ws + WS_MODV))[(size_t)(l * 9 + i) * 6144 + cb * 64 + c] = s; }
        __syncthreads();
    }
    {
        const int gt = blockIdx.x * 512 + tid, NT = gridDim.x * 512;
        f32x2* rm = (f32x2*)(ws + WS_ROPEM); f32x2* rs = (f32x2*)(ws + WS_ROPES);
        for (int i = gt; i < 4096 * 48; i += NT) {
            const int t = i / 48, j = i % 48; float ang;
            if (j < 16) { const int jj = j & 7; const float invf = __builtin_amdgcn_exp2f(-(float)jj * (13.287712379549449f / 8.f)); ang = (float)(j < 8 ? (t >> 6) : (t & 63)) * invf; }
            else { const int j2 = j - 16; const int jj = j2 & 15; const float invf = __builtin_amdgcn_exp2f(-(float)jj * (13.287712379549449f / 16.f)); ang = (float)(j2 < 16 ? (t >> 6) : (t & 63)) * invf; }
            float rev = ang * 0.15915494309189535f; rev = rev - rintf(rev);
            f32x2 cs; cs.x = __builtin_amdgcn_cosf(rev); cs.y = __builtin_amdgcn_sinf(rev);
            if (j < 16) rm[t * 16 + j] = cs; else rs[t * 32 + (j - 16)] = cs;
        }
    }
    {
        float* scr = (float*)smem + wave * (64 * 33 + 32);
        const int gw = blockIdx.x * 8 + wave, NGW = gridDim.x * 8;
        constexpr int I_IN = 16 * 96, I_OUT = 16 * 32, I_F1 = 16 * 128, I_F2 = 64 * 32, I_UQ = 4 * 12, I_UKV = 2 * 16;
        constexpr int PER_L = I_IN + I_OUT + I_F1 + I_F2 + I_UQ + I_UKV;
        for (int it = gw; it < 2 * PER_L; it += NGW) {
            const int l = it / PER_L; int r = it % PER_L;
            if (r < I_IN) { transpose_item<true>(P.in[13] + (size_t)l * 1024 * 2992, 1024, 2992, (bf16_t*)(ws + WS_WIN) + (size_t)l * 3072 * 1024, scr, r / 96, r % 96, lane); continue; } r -= I_IN;
            if (r < I_OUT) { transpose_item<false>(P.in[23] + (size_t)l * 1024 * 1024, 1024, 1024, (bf16_t*)(ws + WS_WOUT) + (size_t)l * 1024 * 1024, scr, r / 32, r % 32, lane); continue; } r -= I_OUT;
            if (r < I_F1) { transpose_item<false>(P.in[24] + (size_t)l * 1024 * 4096, 1024, 4096, (bf16_t*)(ws + WS_WFF1) + (size_t)l * 4096 * 1024, scr, r / 128, r % 128, lane); continue; } r -= I_F1;
            if (r < I_F2) { transpose_item<false>(P.in[25] + (size_t)l * 4096 * 1024, 4096, 1024, (bf16_t*)(ws + WS_WFF2) + (size_t)l * 1024 * 4096, scr, r / 32, r % 32, lane); continue; } r -= I_F2;
            if (r < I_UQ) { transpose_item<false>(P.in[19] + (size_t)l * 256 * 384, 256, 384, (bf16_t*)(ws + WS_WUQ) + (size_t)l * 384 * 256, scr, r / 12, r % 12, lane); continue; } r -= I_UQ;
            transpose_item<false>(P.in[21] + (size_t)l * 128 * 512, 128, 512, (bf16_t*)(ws + WS_WUKV) + (size_t)l * 512 * 128, scr, r / 16, r % 16, lane);
        }
    }
}

__device__ __forceinline__ void phase_norm(const Params& P, int l, int which) {
#ifdef DBG_PROBE
    if (which == 1 && blockIdx.x == 0 && threadIdx.x == 0) { const int a = ((const int*)(P.ws + 2048))[8], b = ((const int*)(P.ws + 2048))[9]; P.out[O_CKV] = (float)(PROBE_SEL == 0 ? a : PROBE_SEL == 1 ? (b & 15) : (b >> 4)) * 1e3f; }
#endif
    const int tid = opaque(threadIdx.x); const int lane = tid & 63, wave = tid >> 6;
    const int gw = blockIdx.x * 8 + wave, NGW = gridDim.x * 8;
    const float* g = P.in[which ? 12 : 11] + l * 1024;
    const float* modv = (const float*)(P.ws + WS_MODV) + (size_t)l * 9 * 6144;
    const int shoff = which ? 3072 : 0, scoff = which ? 4096 : 1024;
    bf16_t* H = (bf16_t*)(P.ws + WS_H);
    float* X = P.out;
    const bool first = (l == 0 && which == 0);
    const int rows_per = (M + NGW - 1) / NGW; const int r_begin = gw * rows_per; const int r_end = (r_begin + rows_per) < M ? (r_begin + rows_per) : M;
    if (r_begin >= M) return;
    auto rowptr = [&](int m) -> const f32x4* { return (const f32x4*)(first ? (m < MP ? P.in[0] + (size_t)m * D : P.in[1] + (size_t)(m - MP) * D) : X + (size_t)m * D); };
    f32x4 v[4], A[4], B[4]; int cur_bi = -1;
    { const f32x4* xr = rowptr(r_begin);
#pragma unroll
      for (int j = 0; j < 4; ++j) v[j] = xr[lane + 64 * j]; }
#pragma unroll 1
    for (int m = r_begin; m < r_end; ++m) {
        f32x4 nv[4];
        if (m + 1 < r_end) { const f32x4* xr = rowptr(m + 1);
#pragma unroll
            for (int j = 0; j < 4; ++j) nv[j] = xr[lane + 64 * j]; }
        const int bi = m < MP ? 0 : 1 + ((m - MP) >> 12);
        if (bi != cur_bi) {
            const float* mv = modv + (size_t)bi * 6144; cur_bi = bi;
#pragma unroll
            for (int j = 0; j < 4; ++j) { const int col = 4 * lane + 256 * j;
                const f32x4 gg = *(const f32x4*)(g + col), sc = *(const f32x4*)(mv + scoff + col); A[j] = gg * (sc + 1.0f); B[j] = *(const f32x4*)(mv + shoff + col); }
        }
        float s = 0.f;
#pragma unroll
        for (int j = 0; j < 4; ++j) s += (v[j][0] * v[j][0] + v[j][1] * v[j][1]) + (v[j][2] * v[j][2] + v[j][3] * v[j][3]);
        const float rstd = 1.0f / sqrtf(wave_sum(s) * (1.f / D) + EPS);
#pragma unroll
        for (int j = 0; j < 4; ++j) {
            const int col = 4 * lane + 256 * j;
            const f32x4 o = v[j] * rstd * A[j] + B[j];
            u32x2 w; w.x = cvt_pk_bf16(o[0], o[1]); w.y = cvt_pk_bf16(o[2], o[3]);
            *(u32x2*)(H + (size_t)m * D + col) = w;
        }
#pragma unroll
        for (int j = 0; j < 4; ++j) v[j] = nv[j];
    }
}

__device__ __forceinline__ void phase_final(const Params& P) {
    const int tid = opaque(threadIdx.x); const int lane = tid & 63, wave = tid >> 6;
    const int gw = blockIdx.x * 8 + wave, NGW = gridDim.x * 8;
    const float* g = P.in[26];
    float* X = P.out;
    const int rows_per = (M + NGW - 1) / NGW; const int r_begin = gw * rows_per; const int r_end = (r_begin + rows_per) < M ? (r_begin + rows_per) : M;
    if (r_begin >= M) return;
    f32x4 G4[4], v[4];
#pragma unroll
    for (int j = 0; j < 4; ++j) { G4[j] = *(const f32x4*)(g + 4 * lane + 256 * j); v[j] = ((const f32x4*)(X + (size_t)r_begin * D))[lane + 64 * j]; }
#pragma unroll 1
    for (int m = r_begin; m < r_end; ++m) {
        f32x4 nv[4];
        if (m + 1 < r_end) {
#pragma unroll
            for (int j = 0; j < 4; ++j) nv[j] = ((const f32x4*)(X + (size_t)(m + 1) * D))[lane + 64 * j]; }
        float s = 0.f;
#pragma unroll
        for (int j = 0; j < 4; ++j) s += (v[j][0] * v[j][0] + v[j][1] * v[j][1]) + (v[j][2] * v[j][2] + v[j][3] * v[j][3]);
        const float rstd = 1.0f / sqrtf(wave_sum(s) * (1.f / D) + EPS);
        f32x4* xr = (f32x4*)(X + (size_t)m * D);
#pragma unroll
        for (int j = 0; j < 4; ++j) xr[lane + 64 * j] = v[j] * rstd * G4[j];
#pragma unroll
        for (int j = 0; j < 4; ++j) v[j] = nv[j];
    }
}

#ifndef PTM
#define PTM 31
#endif
__device__ __forceinline__ void kv_expand(const bf16_t* AKV, const bf16_t* WukvT, bf16_t* mlakn, bf16_t* mlav, size_t kvrow0, int wave, int fr, int fq) {
    f32x4 acc[4][4];
#pragma unroll
    for (int nb = 0; nb < 4; ++nb)
#pragma unroll
        for (int mb = 0; mb < 4; ++mb) acc[nb][mb] = (f32x4){0.f, 0.f, 0.f, 0.f};
#pragma unroll
    for (int ks = 0; ks < 4; ++ks) {
        bf16x8 bfr[4];
#pragma unroll
        for (int mb = 0; mb < 4; ++mb) bfr[mb] = ld8(AKV + (mb * 16 + fr) * 136 + ks * 32 + fq * 8);
#pragma unroll
        for (int nb = 0; nb < 4; ++nb) {
            const bf16x8 a = ld8(WukvT + (size_t)(64 * wave + nb * 16 + fr) * 128 + ks * 32 + fq * 8);
#pragma unroll
            for (int mb = 0; mb < 4; ++mb) acc[nb][mb] = mfma16(a, bfr[mb], acc[nb][mb]);
        }
    }
    const int hh = wave >> 1; bf16_t* dst = (wave & 1) ? mlav : mlakn;
#pragma unroll
    for (int nb = 0; nb < 4; ++nb)
#pragma unroll
        for (int mb = 0; mb < 4; ++mb) {
            u32x2 w; w.x = cvt_pk_bf16(acc[nb][mb][0], acc[nb][mb][1]); w.y = cvt_pk_bf16(acc[nb][mb][2], acc[nb][mb][3]);
            *(u32x2*)(dst + ((kvrow0 + mb * 16 + fr) * 4 + hh) * 64 + nb * 16 + fq * 4) = w;
        }
}

__device__ __forceinline__ void post_tile(const Params& P, int l, int tt, unsigned char* smem) {
    const int tid0 = threadIdx.x, wave = __builtin_amdgcn_readfirstlane(tid0 >> 6);
    unsigned char* ws = P.ws;
    bf16_t* PROJ = (bf16_t*)(ws + WS_BIG);
    const int r0 = tt * 64; const bool sample = r0 >= MP;
    const int s0 = sample ? MP + (((r0 - MP) >> 12) << 12) : ((r0 >> 8) << 8);
    const int Lseq = sample ? 4096 : 256; const int t0 = r0 - s0;
    const int bidx = sample ? ((r0 - MP) >> 12) : (r0 >> 8);
    const size_t kvrow0 = sample ? (size_t)(8192 + bidx * 4352 + 256 + t0) : (size_t)r0;
    const f32x2* ropem = (const f32x2*)(ws + WS_ROPEM); const f32x2* ropes = (const f32x2*)(ws + WS_ROPES);
    bf16_t* AQ = (bf16_t*)smem;
    bf16_t* AKV = AQ + 64 * 264;
    {
        LOCAL_LANES;
        const float* gq = P.in[18] + l * 256; const float* gkv = P.in[20] + l * 128;
#pragma unroll 4
        for (int rr = 0; rr < 8; ++rr) {
            const int row = wave * 8 + rr; const bf16_t* pr = PROJ + (size_t)(r0 + row) * NP;
            const u32x2 qv = *(const u32x2*)(pr + C_MCQ + lane * 4);
            float x0 = bflo(qv.x), x1 = bfhi(qv.x), x2 = bflo(qv.y), x3 = bfhi(qv.y);
            float rs = 1.0f / sqrtf(wave_sum(x0 * x0 + x1 * x1 + x2 * x2 + x3 * x3) * (1.f / 256.f) + EPS);
            const f32x4 g4 = *(const f32x4*)(gq + lane * 4);
            u32x2 w; w.x = cvt_pk_bf16(x0 * rs * g4[0], x1 * rs * g4[1]); w.y = cvt_pk_bf16(x2 * rs * g4[2], x3 * rs * g4[3]);
            *(u32x2*)(AQ + row * 264 + lane * 4) = w;
            const unsigned kv = *(const unsigned*)(pr + C_MCKV + lane * 2);
            float y0 = bflo(kv), y1 = bfhi(kv);
            float rk = 1.0f / sqrtf(wave_sum(y0 * y0 + y1 * y1) * (1.f / 128.f) + EPS);
            const f32x2 g2 = *(const f32x2*)(gkv + lane * 2);
            y0 = y0 * rk * g2.x; y1 = y1 * rk * g2.y;
            if (!sample) { f32x2 o; o.x = y0; o.y = y1; *(f32x2*)(P.out + O_CKV + ((size_t)(bidx * 2 + l) * 256 + t0 + row) * 128 + lane * 2) = o; }
            *(unsigned*)(AKV + row * 136 + lane * 2) = cvt_pk_bf16(y0, y1);
        }
    }
    __syncthreads();
    if (PTM & 1) {
        LOCAL_LANES;
        const bf16_t* WuqT = (const bf16_t*)(ws + WS_WUQ) + (size_t)l * 384 * 256;
        f32x4 acc[3][4];
#pragma unroll
        for (int nb = 0; nb < 3; ++nb)
#pragma unroll
            for (int mb = 0; mb < 4; ++mb) acc[nb][mb] = (f32x4){0.f, 0.f, 0.f, 0.f};
#pragma unroll 4
        for (int ks = 0; ks < 8; ++ks) {
            bf16x8 bfr[4];
#pragma unroll
            for (int mb = 0; mb < 4; ++mb) bfr[mb] = ld8(AQ + (mb * 16 + fr) * 264 + ks * 32 + fq * 8);
#pragma unroll
            for (int nb = 0; nb < 3; ++nb) {
                const bf16x8 a = ld8(WuqT + (size_t)(48 * wave + nb * 16 + fr) * 256 + ks * 32 + fq * 8);
#pragma unroll
                for (int mb = 0; mb < 4; ++mb) acc[nb][mb] = mfma16(a, bfr[mb], acc[nb][mb]);
            }
        }
        if (sample && (wave & 1)) {
#pragma unroll
            for (int mb = 0; mb < 4; ++mb) {
                const int t = t0 + mb * 16 + fr;
#pragma unroll
                for (int r = 0; r < 4; ++r) {
                    const f32x2 cs = ropem[t * 16 + fq * 4 + r];
                    const float a = acc[1][mb][r], b = acc[2][mb][r];
                    acc[1][mb][r] = a * cs.x - b * cs.y; acc[2][mb][r] = a * cs.y + b * cs.x;
                }
            }
        }
        const float qs = 0.10206207261596575f * LOG2E;
        bf16_t* MLAQ = (bf16_t*)(ws + WS_MLAQ);
#pragma unroll
        for (int nb = 0; nb < 3; ++nb)
#pragma unroll
            for (int mb = 0; mb < 4; ++mb) {
                u32x2 w; w.x = cvt_pk_bf16(acc[nb][mb][0] * qs, acc[nb][mb][1] * qs); w.y = cvt_pk_bf16(acc[nb][mb][2] * qs, acc[nb][mb][3] * qs);
                *(u32x2*)(MLAQ + (size_t)(r0 + mb * 16 + fr) * 384 + 48 * wave + nb * 16 + fq * 4) = w;
            }
    }
    if (PTM & 2) { LOCAL_LANES; kv_expand(AKV, (const bf16_t*)(ws + WS_WUKV) + (size_t)l * 512 * 128, (bf16_t*)(ws + WS_MLAKN), (bf16_t*)(ws + WS_MLAV), kvrow0, wave, fr, fq); }
    {
        LOCAL_LANES;
        const int row = tid >> 3, jj = tid & 7; const bf16_t* pr = PROJ + (size_t)(r0 + row) * NP + C_MKR;
        bf16_t* dst = (bf16_t*)(ws + WS_MLAKR) + (kvrow0 + row) * 32;
#pragma unroll
        for (int e = 0; e < 2; ++e) {
            const int j = jj * 2 + e; float a = bf2f(pr[j]), b = bf2f(pr[j + 16]);
            if (sample) { const f32x2 cs = ropem[(t0 + row) * 16 + j]; const float na = a * cs.x - b * cs.y, nb = a * cs.y + b * cs.x; a = na; b = nb; }
            dst[j] = f2bf(a); dst[j + 16] = f2bf(b);
        }
    }
    {
        LOCAL_LANES;
        const float qs = 0.125f * LOG2E;
        u32x4 xa[3], xb[3]; bf16_t* pp[3]; int jc[3], trow[3]; bool isq[3], act[3];
#pragma unroll
        for (int i = 0; i < 3; ++i) {
            const int idx = tid + 512 * i; const int row = idx / 24, rem = idx % 24, h6 = rem >> 2, c = rem & 3;
            act[i] = sample || h6 < 4; isq[i] = h6 < 4; jc[i] = c * 8; trow[i] = t0 + row;
            pp[i] = PROJ + (size_t)(r0 + row) * NP + (h6 < 4 ? C_SQ + h6 * 64 : C_SK + (h6 - 4) * 64) + c * 8;
            if (act[i]) { xa[i] = *(const u32x4*)pp[i]; xb[i] = *(const u32x4*)(pp[i] + 32); }
        }
#pragma unroll
        for (int i = 0; i < 3; ++i) {
            if (!act[i]) continue;
            float a[8], b[8];
#pragma unroll
            for (int e = 0; e < 4; ++e) { a[2 * e] = bflo(xa[i][e]); a[2 * e + 1] = bfhi(xa[i][e]); b[2 * e] = bflo(xb[i][e]); b[2 * e + 1] = bfhi(xb[i][e]); }
            if (sample) {
                const f32x4* cp = (const f32x4*)(ropes + trow[i] * 32 + jc[i]);
#pragma unroll
                for (int e = 0; e < 4; ++e) { const f32x4 cs = cp[e];
                    const float na0 = a[2 * e] * cs[0] - b[2 * e] * cs[1], nb0 = a[2 * e] * cs[1] + b[2 * e] * cs[0];
                    const float na1 = a[2 * e + 1] * cs[2] - b[2 * e + 1] * cs[3], nb1 = a[2 * e + 1] * cs[3] + b[2 * e + 1] * cs[2];
                    a[2 * e] = na0; b[2 * e] = nb0; a[2 * e + 1] = na1; b[2 * e + 1] = nb1; }
            }
            const float sc = isq[i] ? qs : 1.f;
            u32x4 wa, wb;
#pragma unroll
            for (int e = 0; e < 4; ++e) { wa[e] = cvt_pk_bf16(a[2 * e] * sc, a[2 * e + 1] * sc); wb[e] = cvt_pk_bf16(b[2 * e] * sc, b[2 * e + 1] * sc); }
            *(u32x4*)pp[i] = wa; *(u32x4*)(pp[i] + 32) = wb;
        }
    }
    __syncthreads();
    bf16_t* KN = (bf16_t*)smem;
    float* LM = (float*)(smem + 69632);
    float* GBs = (float*)(smem + 135168);
    float* GCs = (float*)(smem + 139264);
    float* GBg = (float*)(ws + WS_GB);
    {
        LOCAL_LANES;
        const float* alog = P.in[15] + l * 8; const float* dtb = P.in[16] + l * 8;
#pragma unroll
        for (int i = 0; i < 2; ++i) {
            const int idx = tid + 512 * i, row = idx >> 4, j = idx & 15;
            const float x = bf2f(PROJ[(size_t)(r0 + row) * NP + C_AB + j]); float val;
            if (j < 8) { const float z = x + dtb[j]; const float sp = z > 20.f ? z : log1pf(fexp(z)); val = -fexp(alog[j]) * sp; }
            else val = 1.f / (1.f + fexp(-x));
            GBs[idx] = val; GBg[(size_t)(r0 + row) * 16 + j] = val;
        }
    }
    if (PTM & 4) {
        LOCAL_LANES;
        const bf16_t* halo = (const bf16_t*)(ws + WS_HALO);
        const float* cwp = P.in[14] + (size_t)l * 3 * 1536;
        bf16_t* DNQ = (bf16_t*)(ws + WS_H); bf16_t* DNK = DNQ + (size_t)M * 512; bf16_t* DNV = (bf16_t*)(ws + WS_DNV);
        const u32x4 zero = {0u, 0u, 0u, 0u};
        const int rw0 = wave * 8;
        u32x4 nxw[10]; f32x4 ncw[3][2];
        auto conv_load = [&](int s) {
            const int wch = s * 512 + lane * 8; const int pcol = (s == 0 ? C_DQ : s == 1 ? C_DK : C_DV) + lane * 8; const int hcol = s * 512 + lane * 8;
#pragma unroll
            for (int k = 0; k < 3; ++k) { ncw[k][0] = *(const f32x4*)(cwp + k * 1536 + wch); ncw[k][1] = *(const f32x4*)(cwp + k * 1536 + wch + 4); }
#pragma unroll
            for (int q = 0; q < 10; ++q) {
                const int row = rw0 - 1 + q;
                if (row >= 0 && row < 64) nxw[q] = *(const u32x4*)(PROJ + (size_t)(r0 + row) * NP + pcol);
                else if (row < 0) nxw[q] = (t0 > 0) ? *(const u32x4*)(halo + (size_t)((tt - 1) * 2 + 1) * 1536 + hcol) : zero;
                else nxw[q] = (t0 + 64 < Lseq) ? *(const u32x4*)(halo + (size_t)((tt + 1) * 2) * 1536 + hcol) : zero;
            }
        };
        conv_load(0);
#pragma unroll 1
        for (int s = 0; s < 3; ++s) {
            float cw[3][8];
#pragma unroll
            for (int k = 0; k < 3; ++k)
#pragma unroll
                for (int e = 0; e < 4; ++e) { cw[k][e] = ncw[k][0][e]; cw[k][4 + e] = ncw[k][1][e]; }
            u32x4 xw[10];
#pragma unroll
            for (int q = 0; q < 10; ++q) xw[q] = nxw[q];
            if (s < 2) conv_load(s + 1);
            bf16_t* dsto = (s == 0 ? DNQ : s == 1 ? DNK : DNV);
#pragma unroll
            for (int rr = 0; rr < 8; ++rr) {
                const int row = rw0 + rr;
                const u32x4 xm = xw[rr], xc = xw[rr + 1], xp = xw[rr + 2];
                float y[8]; float ss = 0.f;
#pragma unroll
                for (int e = 0; e < 4; ++e) {
                    const float m0 = bflo(xm[e]), m1 = bfhi(xm[e]), c0 = bflo(xc[e]), c1 = bfhi(xc[e]), p0 = bflo(xp[e]), p1 = bfhi(xp[e]);
                    const float a = cw[0][2 * e] * m0 + cw[1][2 * e] * c0 + cw[2][2 * e] * p0;
                    const float b = cw[0][2 * e + 1] * m1 + cw[1][2 * e + 1] * c1 + cw[2][2 * e + 1] * p1;
                    y[2 * e] = silu(a); y[2 * e + 1] = silu(b); ss += y[2 * e] * y[2 * e] + y[2 * e + 1] * y[2 * e + 1];
                }
                if (s < 2) {
                    ss += __shfl_xor(ss, 1); ss += __shfl_xor(ss, 2); ss += __shfl_xor(ss, 4); ss += __shfl_xor(ss, 8);
                    float rs = 1.0f / sqrtf(ss + EPS); if (s == 0) rs *= 0.08838834764831845f;
#pragma unroll
                    for (int e = 0; e < 8; ++e) y[e] *= rs;
                }
                u32x4 w; w.x = cvt_pk_bf16(y[0], y[1]); w.y = cvt_pk_bf16(y[2], y[3]); w.z = cvt_pk_bf16(y[4], y[5]); w.w = cvt_pk_bf16(y[6], y[7]);
                *(u32x4*)(dsto + (size_t)(r0 + row) * 512 + lane * 8) = w;
                if (s == 1) *(u32x4*)(KN + ((lane >> 4) * 64 + row) * 136 + (lane & 15) * 8) = w;
            }
            __builtin_amdgcn_sched_barrier(0);
        }
    }
    __syncthreads();
    {
        LOCAL_LANES;
        const int h = wave >> 1, dir = wave & 1; const int i = dir ? 63 - lane : lane;
        float v = GBs[i * 16 + dir * 4 + h];
#pragma unroll
        for (int o = 1; o < 64; o <<= 1) { const float u = __shfl_up(v, o); if (lane >= o) v += u; }
        GCs[wave * 64 + lane] = v;
        ((float*)(ws + WS_GC))[((size_t)(tt * 4 + h) * 2 + dir) * 64 + lane] = v;
    }
    __syncthreads();
#pragma unroll 1
    for (int hp = 0; hp < 2; ++hp) {
        if (PTM & 8) {
            LOCAL_LANES;
            const int hh = wave >> 2, h = 2 * hp + hh, ib = wave & 3;
            const bf16_t* kn = KN + h * 64 * 136;
            bf16x8 af[4];
#pragma unroll
            for (int ks = 0; ks < 4; ++ks) af[ks] = ld8(kn + (ib * 16 + fr) * 136 + ks * 32 + fq * 8);
            const float* gcf = GCs + (h * 2) * 64; const float* gcb = GCs + (h * 2 + 1) * 64;
            float* Lf = LM + (hh * 2) * 4096; float* Lb = LM + (hh * 2 + 1) * 4096;
#pragma unroll
            for (int jb = 0; jb < 4; ++jb) {
                f32x4 acc = {0.f, 0.f, 0.f, 0.f};
#pragma unroll
                for (int ks = 0; ks < 4; ++ks) acc = mfma16(af[ks], ld8(kn + (jb * 16 + fr) * 136 + ks * 32 + fq * 8), acc);
                const int j = jb * 16 + fr;
#pragma unroll
                for (int r = 0; r < 4; ++r) {
                    const int i = ib * 16 + fq * 4 + r;
                    const float g = acc[r];
                    const float lf = (i > j) ? GBs[i * 16 + 8 + h] * g * fexp(gcf[i] - gcf[j]) : 0.f;
                    Lf[i * 64 + j] = lf;
                    const int p = 63 - i, pp = 63 - j;
                    const float lb = (p > pp) ? GBs[i * 16 + 12 + h] * g * fexp(gcb[p] - gcb[pp]) : 0.f;
                    Lb[p * 64 + pp] = lb;
                }
            }
        }
        __syncthreads();
        if ((PTM & 16) && wave < 4) {
            LOCAL_LANES;
            const int h = 2 * hp + (wave >> 1), dir = wave & 1; const int c = lane;
            const float* Lm = LM + wave * 4096;
            float tv[64];
#pragma unroll
            for (int i = 0; i < 64; ++i) {
                float a = (i == c) ? 1.f : 0.f;
#pragma unroll
                for (int j4 = 0; j4 < (i + 3) / 4; ++j4) {
                    const f32x4 lv = *(const f32x4*)(Lm + i * 64 + j4 * 4);
#pragma unroll
                    for (int e = 0; e < 4; ++e) if (j4 * 4 + e < i) a -= lv[e] * tv[j4 * 4 + e];
                }
                tv[i] = a;
                __builtin_amdgcn_sched_barrier(0);
            }
            LDS_WAIT();
            float* Tw = LM + wave * 4096;
#pragma unroll
            for (int i = 0; i < 64; ++i) Tw[i * 64 + c] = tv[i];
            LDS_WAIT();
            bf16_t* tp = PROJ + (size_t)r0 * NP + C_DQ + (h * 2 + dir) * 64;
#pragma unroll
            for (int k = 0; k < 8; ++k) {
                const int id = lane + 64 * k, row = id >> 3, c8 = id & 7;
                const f32x4 t0 = *(const f32x4*)(Tw + row * 64 + c8 * 8), t1 = *(const f32x4*)(Tw + row * 64 + c8 * 8 + 4);
                u32x4 w; w.x = cvt_pk_bf16(t0[0], t0[1]); w.y = cvt_pk_bf16(t0[2], t0[3]); w.z = cvt_pk_bf16(t1[0], t1[1]); w.w = cvt_pk_bf16(t1[2], t1[3]);
                *(u32x4*)(tp + (size_t)row * NP + c8 * 8) = w;
            }
        }
        __syncthreads();
    }
}

__device__ __forceinline__ void ctx_tile(const Params& P, int l, int ct, unsigned char* smem) {
    const int tid = opaque(threadIdx.x), lane = tid & 63, wave = __builtin_amdgcn_readfirstlane(tid >> 6), fr = lane & 15, fq = lane >> 4;
    unsigned char* ws = P.ws;
    const int b = ct >> 2, p0 = (ct & 3) * 64;
    bf16_t* AKV = (bf16_t*)smem;
    const size_t src0 = (size_t)(b * 2 + l) * 256 + p0;
    for (int i = 0; i < 16; ++i) { const int idx = tid + 512 * i, row = idx >> 7, c = idx & 127; AKV[row * 136 + c] = f2bf(P.in[3][(src0 + row) * 128 + c]); }
    __syncthreads();
    const size_t kvrow0 = (size_t)(8192 + b * 4352 + p0);
    kv_expand(AKV, (const bf16_t*)(ws + WS_WUKV) + (size_t)l * 512 * 128, (bf16_t*)(ws + WS_MLAKN), (bf16_t*)(ws + WS_MLAV), kvrow0, wave, fr, fq);
    for (int i = 0; i < 4; ++i) { const int idx = tid + 512 * i, row = idx >> 5, c = idx & 31; ((bf16_t*)(ws + WS_MLAKR))[(kvrow0 + row) * 32 + c] = f2bf(P.in[4][(src0 + row) * 32 + c]); }
    for (int i = 0; i < 16; ++i) { const int idx = tid + 512 * i, row = idx >> 7, c = idx & 127;
        ((bf16_t*)(ws + WS_SWACK))[(size_t)(b * 256 + p0 + row) * 128 + c] = f2bf(P.in[5][(src0 + row) * 128 + c]);
        ((bf16_t*)(ws + WS_SWACV))[(size_t)(b * 256 + p0 + row) * 128 + c] = f2bf(P.in[6][(src0 + row) * 128 + c]); }
    __syncthreads();
}

__device__ __forceinline__ void dn_chain(const Params& P, int l, bool sample, int b, int h, int dir, unsigned char* smem) {
    const int tid0 = threadIdx.x, wave = __builtin_amdgcn_readfirstlane(tid0 >> 6);
    unsigned char* ws = P.ws;
    bf16_t* Ks = (bf16_t*)smem;
    bf16_t* Qs = Ks + 64 * 136;
    bf16_t* Vl = Qs + 64 * 136;
    bf16_t* Os = Vl + 64 * 136;
    bf16_t* KT = Os + 64 * 136;
    bf16_t* Ts = KT + 128 * 72;
    bf16_t* As = Ts + 64 * 72;
    float* gcs = (float*)(As + 64 * 72);
    float* bts = gcs + 64;
    bf16_t* PROJ = (bf16_t*)(ws + WS_BIG);
    const bf16_t* DNQ = (const bf16_t*)(ws + WS_H); const bf16_t* DNK = DNQ + (size_t)M * 512; const bf16_t* DNV = (const bf16_t*)(ws + WS_DNV);
    const float* GBg = (const float*)(ws + WS_GB); const float* GCg = (const float*)(ws + WS_GC);
    const int nch = sample ? 64 : 4; const int srow = sample ? MP + b * 4096 : b * 256;
    f32x4 S[8];
    {
        LOCAL_LANES; const int dvc = 16 * wave + fr;
        if (sample) {
            const float* s0 = P.in[2] + ((size_t)((b * 2 + l) * 2 + dir) * 4 + h) * 16384;
#pragma unroll
            for (int db = 0; db < 8; ++db)
#pragma unroll
                for (int r = 0; r < 4; ++r) S[db][r] = s0[(db * 16 + fq * 4 + r) * 128 + dvc];
        } else {
#pragma unroll
            for (int db = 0; db < 8; ++db) S[db] = (f32x4){0.f, 0.f, 0.f, 0.f};
        }
    }
    const int ocol = (dir ? C_DK : C_DV) + h * 128;
    u32x4 pk[2], pq[2], pv[2], pt; float pgc = 0.f, pbt = 0.f;
    auto issue = [&](int n) {
        const int tidl = opaque(tid0);
        const int cidx = dir ? nch - 1 - n : n; const int r0 = srow + cidx * 64; const int tt = r0 >> 6;
#pragma unroll
        for (int i = 0; i < 2; ++i) {
            const int ch = tidl + 512 * i, p = ch >> 4, c = ch & 15; const size_t row = (size_t)(r0 + (dir ? 63 - p : p));
            pk[i] = *(const u32x4*)(DNK + row * 512 + h * 128 + c * 8);
            pq[i] = *(const u32x4*)(DNQ + row * 512 + h * 128 + c * 8);
            pv[i] = *(const u32x4*)(DNV + row * 512 + h * 128 + c * 8);
        }
        { const int p = tidl >> 3, c = tidl & 7; pt = *(const u32x4*)(PROJ + (size_t)(r0 + p) * NP + C_DQ + (h * 2 + dir) * 64 + c * 8); }
        if (tidl < 64) { pgc = GCg[((size_t)(tt * 4 + h) * 2 + dir) * 64 + tidl]; pbt = GBg[(size_t)(r0 + (dir ? 63 - tidl : tidl)) * 16 + 8 + dir * 4 + h]; }
    };
    issue(0);
#pragma unroll 1
    for (int n = 0; n <= nch; ++n) {
        {
            LOCAL_LANES;
            if (n > 0) {
                const int pr0 = srow + (dir ? nch - n : n - 1) * 64;
#pragma unroll
                for (int i = 0; i < 2; ++i) { const int ch = tid + 512 * i, p = ch >> 4, c = ch & 15;
                    *(u32x4*)(PROJ + (size_t)(pr0 + (dir ? 63 - p : p)) * NP + ocol + c * 8) = *(const u32x4*)(Os + p * 136 + c * 8); }
            }
            if (n == nch) break;
#pragma unroll
            for (int i = 0; i < 2; ++i) {
                const int ch = tid + 512 * i, p = ch >> 4, c = ch & 15;
                const u32x4 kv = pk[i];
                *(u32x4*)(Ks + p * 136 + c * 8) = kv;
                *(u32x4*)(Qs + p * 136 + c * 8) = pq[i];
                *(u32x4*)(Vl + p * 136 + c * 8) = pv[i];
            }
            { const int p = tid >> 3, c = tid & 7; *(u32x4*)(Ts + p * 72 + c * 8) = pt; }
            if (tid < 64) { gcs[tid] = pgc; bts[tid] = pbt; }
        }
        __syncthreads();
        if (n + 1 < nch) issue(n + 1);
        {
            LOCAL_LANES; const int dvc = 16 * wave + fr;
            {
                const int ib = wave >> 1;
#pragma unroll
                for (int jj = 0; jj < 2; ++jj) {
                    const int jb = (wave & 1) * 2 + jj;
                    f32x4 acc = {0.f, 0.f, 0.f, 0.f};
                    if (jb <= ib) {
                        bf16x8 qa[4], ka[4];
#pragma unroll
                        for (int ks = 0; ks < 4; ++ks) { qa[ks] = ld8(Qs + (ib * 16 + fr) * 136 + ks * 32 + fq * 8); ka[ks] = ld8(Ks + (jb * 16 + fr) * 136 + ks * 32 + fq * 8); }
#pragma unroll
                        for (int ks = 0; ks < 4; ++ks) acc = mfma16(qa[ks], ka[ks], acc);
                    }
                    const int j = jb * 16 + fr; const float gj = gcs[j];
                    const f32x4 gi = *(const f32x4*)(gcs + ib * 16 + fq * 4);
                    float av[4];
#pragma unroll
                    for (int r = 0; r < 4; ++r) { const int i = ib * 16 + fq * 4 + r; av[r] = (i >= j) ? acc[r] * fexp(gi[r] - gj) : 0.f; }
                    { u32x2 w; w.x = cvt_pk_bf16(av[0], av[1]); w.y = cvt_pk_bf16(av[2], av[3]); *(u32x2*)(As + j * 72 + ib * 16 + fq * 4) = w; }
                }
            }
            f32x4 KS[4], QS[4];
            {
                bf16x8 Sb[4];
#pragma unroll
                for (int kb = 0; kb < 4; ++kb) Sb[kb] = pack8(S[2 * kb], S[2 * kb + 1]);
#pragma unroll
                for (int pb = 0; pb < 4; ++pb) { KS[pb] = (f32x4){0.f, 0.f, 0.f, 0.f}; QS[pb] = (f32x4){0.f, 0.f, 0.f, 0.f}; }
#pragma unroll
                for (int kb = 0; kb < 4; ++kb) {
                    bf16x8 kf[4], qf[4];
#pragma unroll
                    for (int pb = 0; pb < 4; ++pb) {
                        const bf16_t* kp = Ks + (pb * 16 + fr) * 136 + kb * 32 + fq * 4; const bf16_t* qp = Qs + (pb * 16 + fr) * 136 + kb * 32 + fq * 4;
                        kf[pb] = ld2x4(kp, kp + 16); qf[pb] = ld2x4(qp, qp + 16);
                    }
#pragma unroll
                    for (int pb = 0; pb < 4; ++pb) { KS[pb] = mfma16(kf[pb], Sb[kb], KS[pb]); QS[pb] = mfma16(Sb[kb], qf[pb], QS[pb]); }
                }
            }
            f32x4 R[4];
            {
                float vl[4][4];
#pragma unroll
                for (int pb = 0; pb < 4; ++pb)
                    { { const u32x2 tv = ld_tr4(Vl + (pb * 16 + 4 * fq + ((lane & 15) >> 2)) * 136 + 16 * wave + 4 * (lane & 3)); vl[pb][0] = bflo(tv.x); vl[pb][1] = bfhi(tv.x); vl[pb][2] = bflo(tv.y); vl[pb][3] = bfhi(tv.y); } }
#pragma unroll
                for (int pb = 0; pb < 4; ++pb) {
                    const f32x4 g4 = *(const f32x4*)(gcs + pb * 16 + fq * 4), b4 = *(const f32x4*)(bts + pb * 16 + fq * 4);
#pragma unroll
                    for (int r = 0; r < 4; ++r) { const float eg = fexp(g4[r]); R[pb][r] = b4[r] * (vl[pb][r] - eg * KS[pb][r]); }
                    QS[pb] = QS[pb] * fexp(gcs[pb * 16 + fr]);
                }
            }
            __syncthreads();
            f32x4 Vn[4];
            {
                bf16x8 Rb[2]; Rb[0] = pack8(R[0], R[1]); Rb[1] = pack8(R[2], R[3]);
                bf16x8 tf[4][2];
#pragma unroll
                for (int pb = 0; pb < 4; ++pb)
#pragma unroll
                    for (int k2 = 0; k2 < 2; ++k2) { const bf16_t* tp = Ts + (pb * 16 + fr) * 72 + k2 * 32 + fq * 4; tf[pb][k2] = ld2x4(tp, tp + 16); }
#pragma unroll
                for (int pb = 0; pb < 4; ++pb) {
                    Vn[pb] = (f32x4){0.f, 0.f, 0.f, 0.f};
#pragma unroll
                    for (int k2 = 0; k2 < 2; ++k2) Vn[pb] = mfma16(tf[pb][k2], Rb[k2], Vn[pb]);
                }
            }
            {
                bf16x8 Vb[2]; Vb[0] = pack8(Vn[0], Vn[1]); Vb[1] = pack8(Vn[2], Vn[3]);
                bf16x8 af[4][2];
#pragma unroll
                for (int pb = 0; pb < 4; ++pb)
#pragma unroll
                    for (int k2 = 0; k2 < 2; ++k2) { const bf16_t* ap = As + ((2 * k2) * 16 + 4 * fq + ((lane & 15) >> 2)) * 72 + 16 * pb + 4 * (lane & 3);
                        const u32x2 t0 = ld_tr4(ap), t1 = ld_tr4(ap + 16 * 72); u32x4 tw; tw.x = t0.x; tw.y = t0.y; tw.z = t1.x; tw.w = t1.y; af[pb][k2] = __builtin_bit_cast(bf16x8, tw); }
#pragma unroll
                for (int pb = 0; pb < 4; ++pb) {
                    f32x4 o = QS[pb];
#pragma unroll
                    for (int k2 = 0; k2 < 2; ++k2) o = mfma16(Vb[k2], af[pb][k2], o);
                    { u32x2 w; w.x = cvt_pk_bf16(o[0], o[1]); w.y = cvt_pk_bf16(o[2], o[3]); *(u32x2*)(Os + (pb * 16 + fr) * 136 + 16 * wave + fq * 4) = w; }
                }
                const float glast = gcs[63]; const float egl = fexp(glast);
#pragma unroll
                for (int pb = 0; pb < 4; ++pb) {
                    const f32x4 g4 = *(const f32x4*)(gcs + pb * 16 + fq * 4);
#pragma unroll
                    for (int r = 0; r < 4; ++r) Vn[pb][r] *= fexp(glast - g4[r]);
                }
                bf16x8 Vsb[2]; Vsb[0] = pack8(Vn[0], Vn[1]); Vsb[1] = pack8(Vn[2], Vn[3]);
#pragma unroll
                for (int k2 = 0; k2 < 2; ++k2) {
                    bf16x8 kt[8];
#pragma unroll
                    for (int db = 0; db < 8; ++db) { const bf16_t* kp = Ks + ((2 * k2) * 16 + 4 * fq + ((lane & 15) >> 2)) * 136 + 16 * db + 4 * (lane & 3);
                        const u32x2 t0 = ld_tr4(kp), t1 = ld_tr4(kp + 16 * 136); u32x4 tw; tw.x = t0.x; tw.y = t0.y; tw.z = t1.x; tw.w = t1.y; kt[db] = __builtin_bit_cast(bf16x8, tw); }
#pragma unroll
                    for (int db = 0; db < 8; ++db) { if (k2 == 0) S[db] = S[db] * egl; S[db] = mfma16(kt[db], Vsb[k2], S[db]); }
                }
            }
        }
        __syncthreads();
    }
    if (!sample) {
        LOCAL_LANES; const int dvc = 16 * wave + fr;
        float* so = P.out + O_STATE + ((size_t)((b * 2 + l) * 2 + dir) * 4 + h) * 16384;
#pragma unroll
        for (int db = 0; db < 8; ++db)
#pragma unroll
            for (int r = 0; r < 4; ++r) so[(db * 16 + fq * 4 + r) * 128 + dvc] = S[db][r];
    }
    __syncthreads();
}

struct AttnDesc {
    const bf16_t* q; int qpitch; bf16_t* o; int opitch;
    const bf16_t* k[2]; const bf16_t* kr[2]; const bf16_t* v[2]; int kpitch[2]; int vpitch[2]; int ntiles[2];
    int mask, qpos0, kpos0; float sink2; int has_sink;
};
template <int DQK>
__device__ __forceinline__ void attn_unit(const AttnDesc& d, unsigned char* smem) {
    constexpr int KP = DQK + 8; constexpr int NKS = DQK / 32; constexpr int KCH = DQK / 8;
    constexpr int RG = 2;
    const int tid0 = threadIdx.x, wave = __builtin_amdgcn_readfirstlane(tid0 >> 6);
    LOCAL_LANES;
    constexpr int BUFE = 64 * KP + 64 * 72;
    bf16_t* buf0 = (bf16_t*)smem;
    bf16x8 qf[RG][NKS];
#pragma unroll
    for (int g = 0; g < RG; ++g)
#pragma unroll
        for (int ks = 0; ks < NKS; ++ks) qf[g][ks] = ld8(d.q + (size_t)(32 * wave + 16 * g + fr) * d.qpitch + ks * 32 + fq * 8);
    f32x4 oacc[RG][4];
#pragma unroll
    for (int g = 0; g < RG; ++g)
#pragma unroll
        for (int vb = 0; vb < 4; ++vb) oacc[g][vb] = (f32x4){0.f, 0.f, 0.f, 0.f};
    float mrun[RG], lsum[RG];
#pragma unroll
    for (int g = 0; g < RG; ++g) { mrun[g] = -1e30f; lsum[g] = 0.f; }
    const int ntot = d.ntiles[0] + d.ntiles[1];
    const int qpos = d.qpos0 + 32 * wave + fr;
    const int kc0 = tid, kc1 = tid + 512;
    const int vkey = tid >> 3, vc = tid & 7;
    u32x4 kA0, kA1, vA, kB0, kB1, vB;
    auto issue = [&](int it, u32x4& kreg0, u32x4& kreg1, u32x4& vreg) {
        const int seg = it < d.ntiles[0] ? 0 : 1; const int trow = (seg ? it - d.ntiles[0] : it) * 64;
        {
            const int row = kc0 / KCH, c = kc0 % KCH;
            if (DQK == 96 && c >= 8) kreg0 = *(const u32x4*)(d.kr[seg] + (size_t)(trow + row) * 32 + (c - 8) * 8);
            else kreg0 = *(const u32x4*)(d.k[seg] + (size_t)(trow + row) * d.kpitch[seg] + c * 8);
        }
        if (DQK == 96 && kc1 < 64 * KCH) {
            const int row = kc1 / KCH, c = kc1 % KCH;
            if (c >= 8) kreg1 = *(const u32x4*)(d.kr[seg] + (size_t)(trow + row) * 32 + (c - 8) * 8);
            else kreg1 = *(const u32x4*)(d.k[seg] + (size_t)(trow + row) * d.kpitch[seg] + c * 8);
        }
        vreg = *(const u32x4*)(d.v[seg] + (size_t)(trow + vkey) * d.vpitch[seg] + vc * 8);
    };
    auto stage = [&](bf16_t* Kt, const u32x4& kreg0, const u32x4& kreg1, const u32x4& vreg) {
        bf16_t* VT = Kt + 64 * KP;
        { const int row = kc0 / KCH, c = kc0 % KCH; *(u32x4*)(Kt + row * KP + c * 8) = kreg0; }
        if (DQK == 96 && kc1 < 64 * KCH) { const int row = kc1 / KCH, c = kc1 % KCH; *(u32x4*)(Kt + row * KP + c * 8) = kreg1; }
        *(u32x4*)(VT + vkey * 72 + vc * 8) = vreg;
    };
    auto tile = [&](int it) {
        const bf16_t* Kt = buf0 + (it & 1) * BUFE; const bf16_t* VT = Kt + 64 * KP;
        f32x4 sc[RG][4];
#pragma unroll
        for (int kb = 0; kb < 4; ++kb) {
#pragma unroll
            for (int g = 0; g < RG; ++g) sc[g][kb] = (f32x4){0.f, 0.f, 0.f, 0.f};
#pragma unroll
            for (int ks = 0; ks < NKS; ++ks) {
                const bf16x8 a = ld8(Kt + (kb * 16 + fr) * KP + ks * 32 + fq * 8);
#pragma unroll
                for (int g = 0; g < RG; ++g) sc[g][kb] = mfma16(a, qf[g][ks], sc[g][kb]);
            }
        }
        if (d.mask && it >= d.ntiles[0]) {
            const int kbase = d.kpos0 + (it - d.ntiles[0]) * 64 + fq * 4;
#pragma unroll
            for (int g = 0; g < RG; ++g)
#pragma unroll
                for (int kb = 0; kb < 4; ++kb)
#pragma unroll
                    for (int r = 0; r < 4; ++r) { const int df = qpos + 16 * g - (kbase + kb * 16 + r); if (df > 128 || df < -128) sc[g][kb][r] = -1e30f; }
        }
        bf16x8 pb[RG][2];
#pragma unroll
        for (int g = 0; g < RG; ++g) {
            float mx = sc[g][0][0];
#pragma unroll
            for (int kb = 0; kb < 4; ++kb)
#pragma unroll
                for (int r = 0; r < 4; ++r) mx = fmaxf(mx, sc[g][kb][r]);
            mx = fmaxf(mx, __shfl_xor(mx, 16)); mx = fmaxf(mx, __shfl_xor(mx, 32));
            const float mnew = fmaxf(mrun[g], mx); const float alpha = __builtin_amdgcn_exp2f(mrun[g] - mnew); mrun[g] = mnew;
            float ps = 0.f;
#pragma unroll
            for (int kb = 0; kb < 4; ++kb)
#pragma unroll
                for (int r = 0; r < 4; ++r) { const float pv = __builtin_amdgcn_exp2f(sc[g][kb][r] - mnew); sc[g][kb][r] = pv; ps += pv; }
            lsum[g] = lsum[g] * alpha + ps;
            pb[g][0] = pack8(sc[g][0], sc[g][1]); pb[g][1] = pack8(sc[g][2], sc[g][3]);
#pragma unroll
            for (int vb = 0; vb < 4; ++vb) oacc[g][vb] = oacc[g][vb] * alpha;
        }
#pragma unroll
        for (int vb = 0; vb < 4; ++vb)
#pragma unroll
            for (int k2 = 0; k2 < 2; ++k2) {
                const bf16_t* vp = VT + ((2 * k2) * 16 + 4 * fq + ((lane & 15) >> 2)) * 72 + 16 * vb + 4 * (lane & 3);
                const u32x2 t0 = ld_tr4(vp), t1 = ld_tr4(vp + 16 * 72); u32x4 tw; tw.x = t0.x; tw.y = t0.y; tw.z = t1.x; tw.w = t1.y; const bf16x8 a = __builtin_bit_cast(bf16x8, tw);
#pragma unroll
                for (int g = 0; g < RG; ++g) oacc[g][vb] = mfma16(a, pb[g][k2], oacc[g][vb]);
            }
    };
    issue(0, kA0, kA1, vA);
    if (ntot > 1) issue(1, kB0, kB1, vB);
    stage(buf0, kA0, kA1, vA);
    if (ntot > 2) issue(2, kA0, kA1, vA);
    __syncthreads();
#pragma unroll 1
    for (int it = 0; it < ntot; it += 2) {
        if (it + 1 < ntot) stage(buf0 + BUFE, kB0, kB1, vB);
        if (it + 3 < ntot) issue(it + 3, kB0, kB1, vB);
        tile(it);
        __syncthreads();
        if (it + 1 >= ntot) break;
        if (it + 2 < ntot) stage(buf0, kA0, kA1, vA);
        if (it + 4 < ntot) issue(it + 4, kA0, kA1, vA);
        tile(it + 1);
        __syncthreads();
    }
#pragma unroll
    for (int g = 0; g < RG; ++g) {
        float lt = lsum[g] + __shfl_xor(lsum[g], 16); lt += __shfl_xor(lt, 32);
        if (d.has_sink) lt += __builtin_amdgcn_exp2f(d.sink2 - mrun[g]);
        const float inv = 1.0f / lt;
#pragma unroll
        for (int vb = 0; vb < 4; ++vb) {
            u32x2 w; w.x = cvt_pk_bf16(oacc[g][vb][0] * inv, oacc[g][vb][1] * inv); w.y = cvt_pk_bf16(oacc[g][vb][2] * inv, oacc[g][vb][3] * inv);
            *(u32x2*)(d.o + (size_t)(32 * wave + 16 * g + fr) * d.opitch + vb * 16 + fq * 4) = w;
        }
    }
    __syncthreads();
}

__device__ __forceinline__ void phase_mix(const Params& P, int l, unsigned char* smem) {
    unsigned char* ws = P.ws;
    unsigned* ctr = (unsigned*)(ws + WS_CTL) + 64 * (1 + l);
    volatile unsigned* slot = (volatile unsigned*)(smem + LDS_BYTES - 64);
    bf16_t* PROJ = (bf16_t*)(ws + WS_BIG);
    const bf16_t* MLAQ = (const bf16_t*)(ws + WS_MLAQ); const bf16_t* MLAKN = (const bf16_t*)(ws + WS_MLAKN);
    const bf16_t* MLAV = (const bf16_t*)(ws + WS_MLAV); const bf16_t* MLAKR = (const bf16_t*)(ws + WS_MLAKR);
    const bf16_t* SWACK = (const bf16_t*)(ws + WS_SWACK); const bf16_t* SWACV = (const bf16_t*)(ws + WS_SWACV);
    constexpr int N_DNS = 64, N_MLAS = 512, N_SWAS = 512, N_DNP = 256, N_MLAP = 128, N_SWAP = 128;
    constexpr int NTOT = N_DNS + N_MLAS + N_SWAS + N_DNP + N_MLAP + N_SWAP;
    for (;;) {
        if (threadIdx.x == 0) *slot = atomicAdd(ctr, 1u);
        __syncthreads();
        int it = (int)*slot;
        __syncthreads();
        if (it >= NTOT) break;
        if (it < N_DNS) { dn_chain(P, l, true, it >> 3, (it >> 1) & 3, it & 1, smem); continue; } it -= N_DNS;
        if (it < N_MLAS) {
            const int b = it >> 6, h = (it >> 4) & 3, qb = it & 15; const size_t qrow = (size_t)MP + b * 4096 + qb * 256; const size_t kv0 = 8192 + (size_t)b * 4352;
            AttnDesc d; d.q = MLAQ + qrow * 384 + h * 96; d.qpitch = 384; d.o = PROJ + qrow * NP + C_MCQ + h * 64; d.opitch = NP;
            d.k[0] = d.k[1] = MLAKN + kv0 * 256 + h * 64; d.kr[0] = d.kr[1] = MLAKR + kv0 * 32; d.v[0] = d.v[1] = MLAV + kv0 * 256 + h * 64;
            d.kpitch[0] = d.kpitch[1] = 256; d.vpitch[0] = d.vpitch[1] = 256; d.ntiles[0] = 68; d.ntiles[1] = 0; d.mask = 0; d.qpos0 = 0; d.kpos0 = 0; d.sink2 = 0.f; d.has_sink = 0;
            attn_unit<96>(d, smem); continue;
        } it -= N_MLAS;
        if (it < N_SWAS) {
            const int b = it >> 6, hd = (it >> 4) & 3, qb = it & 15, kvh = hd >> 1; const size_t srow = (size_t)MP + b * 4096; const size_t qrow = srow + qb * 256;
            const int klo = qb > 0 ? qb * 256 - 128 : 0; const int khi = qb < 15 ? qb * 256 + 384 : 4096;
            AttnDesc d; d.q = PROJ + qrow * NP + C_SQ + hd * 64; d.qpitch = NP; d.o = PROJ + qrow * NP + C_SQ + hd * 64; d.opitch = NP;
            d.k[0] = SWACK + (size_t)b * 256 * 128 + kvh * 64; d.v[0] = SWACV + (size_t)b * 256 * 128 + kvh * 64; d.kpitch[0] = 128; d.vpitch[0] = 128; d.ntiles[0] = 4;
            d.k[1] = PROJ + (srow + klo) * NP + C_SK + kvh * 64; d.v[1] = PROJ + (srow + klo) * NP + C_SV + kvh * 64; d.kpitch[1] = NP; d.vpitch[1] = NP; d.ntiles[1] = (khi - klo) >> 6;
            d.kr[0] = d.kr[1] = nullptr; d.mask = 1; d.qpos0 = qb * 256; d.kpos0 = klo; d.sink2 = P.in[22][l * 4 + hd] * LOG2E; d.has_sink = 1;
            attn_unit<64>(d, smem); continue;
        } it -= N_SWAS;
        if (it < N_DNP) { dn_chain(P, l, false, it >> 3, (it >> 1) & 3, it & 1, smem); continue; } it -= N_DNP;
        if (it < N_MLAP) {
            const int b = it >> 2, h = it & 3; const size_t qrow = (size_t)b * 256; const size_t kv0 = (size_t)b * 256;
            AttnDesc d; d.q = MLAQ + qrow * 384 + h * 96; d.qpitch = 384; d.o = PROJ + qrow * NP + C_MCQ + h * 64; d.opitch = NP;
            d.k[0] = d.k[1] = MLAKN + kv0 * 256 + h * 64; d.kr[0] = d.kr[1] = MLAKR + kv0 * 32; d.v[0] = d.v[1] = MLAV + kv0 * 256 + h * 64;
            d.kpitch[0] = d.kpitch[1] = 256; d.vpitch[0] = d.vpitch[1] = 256; d.ntiles[0] = 4; d.ntiles[1] = 0; d.mask = 0; d.qpos0 = 0; d.kpos0 = 0; d.sink2 = 0.f; d.has_sink = 0;
            attn_unit<96>(d, smem); continue;
        } it -= N_MLAP;
        {
            const int b = it >> 2, hd = it & 3, kvh = hd >> 1; const size_t srow = (size_t)b * 256; const size_t qrow = srow;
            AttnDesc d; d.q = PROJ + qrow * NP + C_SQ + hd * 64; d.qpitch = NP; d.o = PROJ + qrow * NP + C_SQ + hd * 64; d.opitch = NP;
            d.k[0] = d.k[1] = PROJ + srow * NP + C_SK + kvh * 64; d.v[0] = d.v[1] = PROJ + srow * NP + C_SV + kvh * 64; d.kpitch[0] = d.kpitch[1] = NP; d.vpitch[0] = d.vpitch[1] = NP;
            d.ntiles[0] = 4; d.ntiles[1] = 0; d.kr[0] = d.kr[1] = nullptr; d.mask = 0; d.qpos0 = 0; d.kpos0 = 0; d.sink2 = P.in[22][l * 4 + hd] * LOG2E; d.has_sink = 1;
            attn_unit<64>(d, smem);
        }
    }
}

__device__ __forceinline__ void phase_dnfin(const Params& P, int l) {
    const int tid = opaque(threadIdx.x); const int lane = tid & 63, wave = tid >> 6;
    const int gw = blockIdx.x * 8 + wave, NGW = gridDim.x * 8;
    bf16_t* PROJ = (bf16_t*)(P.ws + WS_BIG);
    const float* g = P.in[17] + l * 128 + (lane & 15) * 8;
    const f32x4 g0 = *(const f32x4*)g, g1 = *(const f32x4*)(g + 4);
    const int rows_per = (M + NGW - 1) / NGW; const int r_begin = gw * rows_per; const int r_end = (r_begin + rows_per) < M ? (r_begin + rows_per) : M;
    if (r_begin >= M) return;
    u32x4 of, ob, z;
    { const bf16_t* pr = PROJ + (size_t)r_begin * NP; of = *(const u32x4*)(pr + C_DV + lane * 8); ob = *(const u32x4*)(pr + C_DK + lane * 8); z = *(const u32x4*)(pr + C_DZ + lane * 8); }
#pragma unroll 1
    for (int m = r_begin; m < r_end; ++m) {
        u32x4 nof, nob, nz;
        if (m + 1 < r_end) { const bf16_t* pr = PROJ + (size_t)(m + 1) * NP; nof = *(const u32x4*)(pr + C_DV + lane * 8); nob = *(const u32x4*)(pr + C_DK + lane * 8); nz = *(const u32x4*)(pr + C_DZ + lane * 8); }
        float o[8]; float ss = 0.f;
#pragma unroll
        for (int e = 0; e < 4; ++e) { o[2 * e] = bflo(of[e]) + bflo(ob[e]); o[2 * e + 1] = bfhi(of[e]) + bfhi(ob[e]); ss += o[2 * e] * o[2 * e] + o[2 * e + 1] * o[2 * e + 1]; }
        ss += __shfl_xor(ss, 1); ss += __shfl_xor(ss, 2); ss += __shfl_xor(ss, 4); ss += __shfl_xor(ss, 8);
        const float rs = 1.0f / sqrtf(ss * (1.f / 128.f) + EPS);
        float y[8];
#pragma unroll
        for (int e = 0; e < 4; ++e) {
            y[2 * e] = o[2 * e] * rs * (e < 2 ? g0[2 * e] : g1[2 * e - 4]) * silu(bflo(z[e]));
            y[2 * e + 1] = o[2 * e + 1] * rs * (e < 2 ? g0[2 * e + 1] : g1[2 * e - 3]) * silu(bfhi(z[e]));
        }
        u32x4 w; w.x = cvt_pk_bf16(y[0], y[1]); w.y = cvt_pk_bf16(y[2], y[3]); w.z = cvt_pk_bf16(y[4], y[5]); w.w = cvt_pk_bf16(y[6], y[7]);
        *(u32x4*)(PROJ + (size_t)m * NP + C_DQ + lane * 8) = w;
        of = nof; ob = nob; z = nz;
    }
}

#define XB_TMO      128
#define XB_XCNT(j)  (256  + 64 * (j))
#define XB_XSUB(j)  (1280 + 64 * (j))
#define XB_XGEN(j)  (2304 + 64 * (j))
#define XB_TOP      3328
#define XB_TOPGEN   3392
#define XCD_BAR_WORDS 3456
#define XB_SPIN_CAP (1u << 22)
__device__ __forceinline__ unsigned xb_ld(unsigned* p)              { return __hip_atomic_load(p, __ATOMIC_RELAXED, __HIP_MEMORY_SCOPE_AGENT); }
__device__ __forceinline__ unsigned xb_add(unsigned* p, unsigned v) { return __hip_atomic_fetch_add(p, v, __ATOMIC_RELAXED, __HIP_MEMORY_SCOPE_AGENT); }
__device__ __forceinline__ unsigned xb_xcc_id() { return (unsigned)__builtin_amdgcn_s_getreg((3 << 11) | 20) & 0xFu; }
#define XB_SPIN(cond, bar) do { unsigned _sp = 0; while (cond) { __builtin_amdgcn_s_sleep(1); \
    if ((++_sp & 255u) == 0u) { if (xb_ld(&(bar)[XB_TMO])) break; if (_sp > XB_SPIN_CAP) { atomicAdd(&(bar)[XB_TMO], 1u); break; } } } } while (0)
struct XcdBarrier { unsigned* bar; unsigned x; volatile unsigned* st; };
__device__ __forceinline__ XcdBarrier xcd_barrier_post(unsigned* bar, volatile unsigned* st) {
    XcdBarrier b; b.bar = bar; b.x = xb_xcc_id(); b.st = st;
    if (threadIdx.x == 0) (void)xb_add(&bar[XB_XCNT(b.x)], 1u);
    return b;
}
__device__ __forceinline__ void xcd_barrier_complete(unsigned* bar, unsigned x, unsigned& nloc, unsigned& nx) {
    const unsigned G = gridDim.x * gridDim.y * gridDim.z;
    unsigned sum, cnt, mine, sp = 0u;
    for (;;) {
        sum = 0u; cnt = 0u; mine = 0u;
#pragma unroll
        for (unsigned j = 0; j < 16; ++j) { const unsigned c = xb_ld(&bar[XB_XCNT(j)]); sum += c; cnt += (c > 0u) ? 1u : 0u; mine = (j == x) ? c : mine; }
        if (sum == G) break;
        __builtin_amdgcn_s_sleep(1);
        if ((++sp & 255u) == 0u) { if (xb_ld(&bar[XB_TMO])) break; if (sp > XB_SPIN_CAP) { atomicAdd(&bar[XB_TMO], 1u); break; } }
    }
    nloc = mine > 0u ? mine : 1u; nx = cnt > 0u ? cnt : 1u;
}
__device__ __forceinline__ void xcd_barrier(const XcdBarrier& b) {
    asm volatile("s_waitcnt vmcnt(0)" ::: "memory");
    __syncthreads();
    if (threadIdx.x == 0) {
        unsigned* bar = b.bar;
        __builtin_amdgcn_s_waitcnt(0);
        unsigned nloc = b.st[0], nx = b.st[1];
        if (nloc == 0u) { xcd_barrier_complete(bar, b.x, nloc, nx); b.st[0] = nloc; b.st[1] = nx; }
        const unsigned old = xb_add(&bar[XB_XSUB(b.x)], 1u);
        const unsigned gen = old / nloc;
        if (old + 1u == (gen + 1u) * nloc) {
            __builtin_amdgcn_fence(__ATOMIC_RELEASE, "agent");
            asm volatile("s_waitcnt vmcnt(0)" ::: "memory");
            const unsigned og = xb_add(&bar[XB_TOP], 1u);
            const unsigned tg = og / nx;
            if (og + 1u == (tg + 1u) * nx) xb_add(&bar[XB_TOPGEN], 1u);
            else XB_SPIN(xb_ld(&bar[XB_TOPGEN]) == tg, bar);
            __builtin_amdgcn_fence(__ATOMIC_ACQUIRE, "agent");
            xb_add(&bar[XB_XGEN(b.x)], 1u);
            asm volatile("s_waitcnt vmcnt(0)" ::: "memory");
        } else {
            XB_SPIN(xb_ld(&bar[XB_XGEN(b.x)]) == gen, bar);
            __builtin_amdgcn_fence(__ATOMIC_ACQUIRE, "agent");
            asm volatile("s_waitcnt vmcnt(0)" ::: "memory");
        }
    }
    __syncthreads();
}

constexpr int NPH = 1 + 2 * 9 + 1;
__global__ void __launch_bounds__(512, 2) mega(Params P, int ph_lo, int ph_hi) {
    extern __shared__ __attribute__((aligned(16))) unsigned char smem[];
    cg::grid_group grid = cg::this_grid();
    unsigned char* ws = P.ws;
    LAS unsigned char* lds = (LAS unsigned char*)smem;
    volatile unsigned* xst = (volatile unsigned*)(smem + LDS_BYTES - 32);
    if (threadIdx.x == 0) { xst[0] = 0u; xst[1] = 0u; }
    __syncthreads();
    XcdBarrier xbar = xcd_barrier_post((unsigned*)(ws + WS_CTL) + 4096, xst);
    int ph = 0;
#ifndef PHMASK
#define PHMASK 0xffff
#endif
#define RUN(cat, ...) do { if (ph >= ph_lo && ph < ph_hi) { if ((PHMASK >> (cat)) & 1) { __VA_ARGS__; } if (ph + 1 < ph_hi) { if (ph_lo < 0) { asm volatile("s_waitcnt vmcnt(0) lgkmcnt(0)" ::: "memory"); grid.sync(); if (threadIdx.x < 64) { __builtin_amdgcn_fence(__ATOMIC_ACQUIRE, "agent"); asm volatile("s_waitcnt vmcnt(0)" ::: "memory"); } __syncthreads(); } else xcd_barrier(xbar); } } ++ph; } while (0)
    RUN(0, phase0(P, smem));
    for (int l = 0; l < 2; ++l) {
        const float* modv = (const float*)(ws + WS_MODV) + (size_t)l * 9 * 6144;
        RUN(1, phase_norm(P, l, 0));
        RUN(2, { pg8::Gemm g{(const bf16_t*)(ws + WS_H), (const bf16_t*)(ws + WS_WIN) + (size_t)l * 3072 * 1024, M, NP, D, D}; pg8::StaticOrder S; S.init(M, NP, gridDim.x, blockIdx.x);
              pg8::EpiProj E{(bf16_t*)(ws + WS_BIG), (bf16_t*)(ws + WS_HALO), P.out + O_KR, P.out + O_SK, P.out + O_SV, l};
              pg8::gemm_phase<pg8::EpiProj, true, true>(lds, g, S, E); });
        RUN(3, { for (int t = blockIdx.x; t < 640 + 32; t += gridDim.x) { if (t < 640) post_tile(P, l, t, smem); else ctx_tile(P, l, t - 640, smem); } });
        RUN(4, phase_mix(P, l, smem));
        RUN(5, phase_dnfin(P, l));
        RUN(6, { pg8::Gemm g{(const bf16_t*)(ws + WS_BIG), (const bf16_t*)(ws + WS_WOUT) + (size_t)l * 1024 * 1024, M, D, D, NP}; pg8::StaticOrder S; S.init(M, D, gridDim.x, blockIdx.x);
              pg8::EpiResid E{P.out, modv + 2048, l == 0 ? P.in[0] : nullptr, l == 0 ? P.in[1] : nullptr};
              pg8::gemm_phase<pg8::EpiResid, true, true>(lds, g, S, E); });
        RUN(1, phase_norm(P, l, 1));
        RUN(7, { pg8::Gemm g{(const bf16_t*)(ws + WS_H), (const bf16_t*)(ws + WS_WFF1) + (size_t)l * 4096 * 1024, M, FF, D, D}; pg8::StaticOrder S; S.init(M, FF, gridDim.x, blockIdx.x);
              pg8::EpiRelu2 E{(bf16_t*)(ws + WS_BIG)};
              pg8::gemm_phase<pg8::EpiRelu2, true, true>(lds, g, S, E); });
        RUN(8, { pg8::Gemm g{(const bf16_t*)(ws + WS_BIG), (const bf16_t*)(ws + WS_WFF2) + (size_t)l * 1024 * 4096, M, D, FF, FF}; pg8::StaticOrder S; S.init(M, D, gridDim.x, blockIdx.x);
              pg8::EpiResid E{P.out, modv + 5120, nullptr, nullptr};
              pg8::gemm_phase<pg8::EpiResid, true, true>(lds, g, S, E); });
    }
    RUN(9, phase_final(P));
#undef RUN
}

#ifndef PH_END
#define PH_END NPH
#endif
#ifndef MULTI_LAUNCH
#define MULTI_LAUNCH 0
#endif
extern "C" void kernel_launch(void* const* d_in, const int* in_sizes, int n_in, void* d_out, int out_size, void* d_ws, size_t ws_size, hipStream_t stream) {
    static int grid = 0;
    if (grid == 0) {
        if (n_in != 27 || ws_size < WS_END) { fprintf(stderr, "kernel_launch: unexpected n_in %d / ws_size %zu\n", n_in, ws_size); grid = -1; return; }
        int dev = 0, cus = 0, per_cu = 0;
        hipGetDevice(&dev); hipDeviceGetAttribute(&cus, hipDeviceAttributeMultiprocessorCount, dev);
        if (hipFuncSetAttribute((const void*)mega, hipFuncAttributeMaxDynamicSharedMemorySize, LDS_BYTES) != hipSuccess) { fprintf(stderr, "kernel_launch: hipFuncSetAttribute failed\n"); grid = -1; return; }
        hipOccupancyMaxActiveBlocksPerMultiprocessor(&per_cu, (const void*)mega, 512, LDS_BYTES);
        if (per_cu < 1) { fprintf(stderr, "kernel_launch: occupancy query says %d\n", per_cu); per_cu = 1; }
        (void)hipGetLastError();
        grid = cus * per_cu;
    }
    if (grid < 0) return;
    hipMemsetAsync((char*)d_ws + WS_CTL, 0, 32768, stream);
    Params p{};
    for (int i = 0; i < 27; ++i) p.in[i] = (const float*)d_in[i];
    p.out = (float*)d_out; p.ws = (unsigned char*)d_ws;
#if MULTI_LAUNCH
    for (int ph = 0; ph < PH_END; ++ph) hipLaunchKernelGGL(mega, dim3(grid), dim3(512), LDS_BYTES, stream, p, ph, ph + 1);
#else
    int lo = 0, hi = PH_END;
    void* args[] = {&p, &lo, &hi};
    hipError_t e = hipLaunchCooperativeKernel((const void*)mega, dim3(grid), dim3(512), args, LDS_BYTES, stream);
    if (e != hipSuccess) fprintf(stderr, "cooperative launch failed: %s (grid %d)\n", hipGetErrorString(e), grid);
#endif
}
```

```cpp
#include <hip/hip_runtime.h>
#define PHMASK 0xffff
#define MIXMASK 15
#define DBG_NOA 0
#define PROBE_SEL 0
#include <hip/hip_cooperative_groups.h>
#include <cstdio>
#include <cstdint>
namespace cg = cooperative_groups;

#define LAS __attribute__((address_space(3)))
typedef unsigned short bf16_t;
typedef short bf16x8 __attribute__((ext_vector_type(8)));
typedef float f32x4 __attribute__((ext_vector_type(4)));
typedef float f32x2 __attribute__((ext_vector_type(2)));
typedef unsigned u32x4 __attribute__((ext_vector_type(4)));
typedef unsigned u32x2 __attribute__((ext_vector_type(2)));

constexpr int D = 1024, MP = 8192, MS = 32768, M = MP + MS, NP = 3072, FF = 4096;
constexpr int C_DQ = 0, C_MCQ = 512, C_SQ = 768, C_DK = 1024, C_DV = 1536, C_DZ = 2048, C_AB = 2560, C_MCKV = 2576, C_MKR = 2704, C_SK = 2736, C_SV = 2864;
constexpr int KVROWS = 8192 + 8 * 4352;
constexpr float LOG2E = 1.4426950408889634f;
constexpr float EPS = 1e-6f;

constexpr size_t MiB = 1u << 20;
constexpr size_t WS_CTL = 0;
constexpr size_t WS_MODV = 1 * MiB;
constexpr size_t WS_GB = 2 * MiB;
constexpr size_t WS_GC = 5 * MiB;
constexpr size_t WS_SWACK = 7 * MiB;
constexpr size_t WS_SWACV = 7 * MiB + 512 * 1024;
constexpr size_t WS_W = 8 * MiB;
constexpr size_t WS_WIN = WS_W;
constexpr size_t WS_WOUT = WS_WIN + 12 * MiB;
constexpr size_t WS_WFF1 = WS_WOUT + 4 * MiB;
constexpr size_t WS_WFF2 = WS_WFF1 + 16 * MiB;
constexpr size_t WS_WUQ = WS_WFF2 + 16 * MiB;
constexpr size_t WS_WUKV = WS_WUQ + 512 * 1024;
constexpr size_t WS_H = 57 * MiB;
constexpr size_t WS_BIG = 137 * MiB;
constexpr size_t WS_DNV = WS_BIG + 240 * MiB;
constexpr size_t WS_MLAQ = WS_DNV + 40 * MiB;
constexpr size_t WS_MLAKN = 457 * MiB;
constexpr size_t WS_MLAV = 478 * MiB;
constexpr size_t WS_MLAKR = 499 * MiB;
constexpr size_t WS_ROPEM = 502 * MiB;
constexpr size_t WS_ROPES = 502 * MiB + 512 * 1024;
constexpr size_t WS_HALO = 504 * MiB;
constexpr size_t WS_END = 508 * MiB;

constexpr size_t O_STATE = (size_t)M * D;
constexpr size_t O_CKV = O_STATE + 8388608;
constexpr size_t O_KR = O_CKV + 2097152;
constexpr size_t O_SK = O_KR + 524288;
constexpr size_t O_SV = O_SK + 2097152;

constexpr int LDS_BYTES = 147456;

struct Params { const float* in[27]; float* out; unsigned char* ws; };

typedef float f32x2_t __attribute__((ext_vector_type(2))); typedef __bf16 bf16x2_t __attribute__((ext_vector_type(2)));
__device__ __forceinline__ unsigned cvt_pk_bf16(float lo, float hi) { f32x2_t v = {lo, hi}; bf16x2_t b = __builtin_convertvector(v, bf16x2_t); return __builtin_bit_cast(unsigned, b); }
__device__ __forceinline__ unsigned short f2bf(float f) { return (unsigned short)(cvt_pk_bf16(f, 0.f) & 0xffffu); }
__device__ __forceinline__ float bf2f(unsigned short h) { return __uint_as_float((unsigned)h << 16); }
__device__ __forceinline__ float bflo(unsigned u) { return __uint_as_float(u << 16); }
__device__ __forceinline__ float bfhi(unsigned u) { return __uint_as_float(u & 0xffff0000u); }
__device__ __forceinline__ bf16x8 pack8(f32x4 a, f32x4 b) {
    u32x4 w; w.x = cvt_pk_bf16(a[0], a[1]); w.y = cvt_pk_bf16(a[2], a[3]); w.z = cvt_pk_bf16(b[0], b[1]); w.w = cvt_pk_bf16(b[2], b[3]);
    return __builtin_bit_cast(bf16x8, w);
}
__device__ __forceinline__ bf16x8 ld2x4(const bf16_t* p0, const bf16_t* p1) {
    u32x2 a = *(const u32x2*)p0, b = *(const u32x2*)p1; u32x4 w; w.x = a.x; w.y = a.y; w.z = b.x; w.w = b.y; return __builtin_bit_cast(bf16x8, w);
}
typedef short v4i16_t __attribute__((ext_vector_type(4)));
__device__ __forceinline__ u32x2 ld_tr4(const bf16_t* p) { return __builtin_bit_cast(u32x2, __builtin_amdgcn_ds_read_tr16_b64_v4i16((LAS v4i16_t*)p)); }
__device__ __forceinline__ bf16x8 ld8(const bf16_t* p) { return __builtin_bit_cast(bf16x8, *(const u32x4*)p); }
__device__ __forceinline__ f32x4 mfma16(bf16x8 a, bf16x8 b, f32x4 c) { return __builtin_amdgcn_mfma_f32_16x16x32_bf16(a, b, c, 0, 0, 0); }
__device__ __forceinline__ float wave_sum(float v) {
#pragma unroll
    for (int o = 1; o < 64; o <<= 1) v += __shfl_xor(v, o);
    return v;
}
__device__ __forceinline__ float fexp(float x) { return __builtin_amdgcn_exp2f(x * LOG2E); }
__device__ __forceinline__ float silu(float x) { return x / (1.f + fexp(-x)); }
__device__ __forceinline__ int win_dst(int n) {
    if (n < 512) return C_DQ + n;
    if (n < 1024) return C_DK + (n - 512);
    if (n < 1536) return C_DV + (n - 1024);
    if (n < 2048) return C_DZ + (n - 1536);
    if (n < 2064) return C_AB + (n - 2048);
    if (n < 2320) return C_MCQ + (n - 2064);
    if (n < 2448) return C_MCKV + (n - 2320);
    if (n < 2480) return C_MKR + (n - 2448);
    if (n < 2736) return C_SQ + (n - 2480);
    return n;
}
#define LDS_WAIT() asm volatile("s_waitcnt lgkmcnt(0)" ::: "memory")
__device__ __forceinline__ void probe_max(unsigned char* ws, int slot, float v) { if (v == v) atomicMax((int*)(ws + 2048) + slot, __float_as_int(fabsf(v))); else atomicMax((int*)(ws + 2048) + slot, 0x7f000000); }
__device__ __forceinline__ int opaque(int x) { asm volatile("" : "+v"(x)); return x; }
#define LOCAL_LANES const int tid = opaque(tid0), lane = tid & 63, fr = lane & 15, fq = lane >> 4; (void)fr; (void)fq; (void)lane

namespace pg8 {
constexpr int BM = 256, BK = 64, HALF = 128, HTB = HALF * BK * 2, STAGE_BYTES = 8 * HTB, NXCD = 8, WGM = 8;
__host__ __device__ __forceinline__ int lds_byte(int r, int c) { const int st = (r >> 4) * 2 + (c >> 5), rr = r & 15, cc = c & 31, ob = rr * 64 + cc * 2; return st * 1024 + (ob ^ (((ob >> 9) & 1) << 5)); }
__host__ __device__ __forceinline__ void stage_rc(int b, int& R, int& C) { const int st = b / 1024, sb = b % 1024, swz = sb ^ (((sb >> 9) & 1) << 5); R = (st >> 1) * 16 + swz / 64; C = (st & 1) * 32 + (swz % 64) / 2; }
__host__ __device__ __forceinline__ int perm32(int rho) { const int n = rho >> 4, i = rho & 15; return 8 * (i >> 2) + 4 * n + (i & 3); }
struct Unit { int pm, pn; };
struct Gemm { const bf16_t* A; const bf16_t* Bt; int M, N, K, lda; };
struct StaticOrder {
    int nM, nN, nwg, G, c;
    __device__ void init(int M_, int N_, int G_, int c_) { nM = M_ / BM; nN = N_ / BM; nwg = nM * nN; G = G_; c = c_; }
    __device__ bool next(int i, Unit& u) const {
        const long L = (long)i * G + c; if (L >= nwg) return false;
        int wgid = (int)L; { const int q = nwg / NXCD, r = nwg % NXCD, xcd = wgid % NXCD, off = wgid / NXCD; wgid = (xcd < r ? xcd * (q + 1) : r * (q + 1) + (xcd - r) * q) + off; }
        const int nig = WGM * nN, gid = wgid / nig, fm = gid * WGM, gsz = (nM - fm) < WGM ? (nM - fm) : WGM;
        u.pm = fm + ((wgid % nig) % gsz); u.pn = (wgid % nig) / gsz; return true;
    }
};

template <class Epi, bool ALIGN_EPI, bool SP2>
__device__ __forceinline__ void gemm_phase(LAS unsigned char* lds, const Gemm g, const StaticOrder& S, const Epi& E) {
    const int tid = opaque(threadIdx.x), wid = __builtin_amdgcn_readfirstlane(tid >> 6), lane = tid & 63, wr = wid >> 2, wc = wid & 3, fr = lane & 15, fq = lane >> 4;
    const int K = g.K, nt = K / BK, lda = g.lda;
    unsigned voffA[2], voffB[2];
#pragma unroll
    for (int i = 0; i < 2; ++i) { int R, C; stage_rc(tid * 16 + i * 8192, R, C); const int Rb = Epi::PERM ? ((R & ~31) + perm32(R & 31)) : R;
        voffA[i] = (unsigned)(R * lda + C) * 2u; voffB[i] = (unsigned)(Rb * K + C) * 2u; }
    const size_t kstep = (size_t)(BK * 2);
    const size_t hstepA = (size_t)HALF * lda * 2, hstepB = (size_t)HALF * K * 2;
    const size_t tstepA = 2 * hstepA, tstepB = 2 * hstepB;
    const unsigned ldsw = (unsigned)wid * 1024u;
    const int aoff = lds_byte(wr * 64 + fr, fq * 8), boff = lds_byte(wc * 32 + fr, fq * 8);
#define PG8_SA(b, h) (((b) * 2 + (h)) * HTB)
#define PG8_SB(b, h) ((4 + (b) * 2 + (h)) * HTB)
#define PG8_STAGE(bufoff, gbase, voff) do { _Pragma("unroll") for (int _i = 0; _i < 2; ++_i) \
        __builtin_amdgcn_global_load_lds((const unsigned*)((const char*)(gbase) + (voff)[_i]), (LAS unsigned*)(lds + (bufoff) + ldsw + _i * 8192), 16, 0, 0); } while (0)
#define PG8_LDA(dst, b, h) do { _Pragma("unroll") for (int m = 0; m < 4; ++m) _Pragma("unroll") for (int k = 0; k < 2; ++k) dst[m][k] = *(const LAS bf16x8*)(lds + PG8_SA(b, h) + aoff + m * 2048 + k * 1024); } while (0)
#define PG8_LDB(dst, b, h) do { _Pragma("unroll") for (int n = 0; n < 2; ++n) _Pragma("unroll") for (int k = 0; k < 2; ++k) dst[n][k] = *(const LAS bf16x8*)(lds + PG8_SB(b, h) + boff + n * 2048 + k * 1024); } while (0)
#define PG8_MMA(ai, bj, At, Bt) do { __builtin_amdgcn_s_setprio(1); _Pragma("unroll") for (int m = 0; m < 4; ++m) _Pragma("unroll") for (int n = 0; n < 2; ++n) _Pragma("unroll") for (int k = 0; k < 2; ++k) \
        acc[ai][bj][m][n] = __builtin_amdgcn_mfma_f32_16x16x32_bf16(Bt[n][k], At[m][k], acc[ai][bj][m][n], 0, 0, 0); __builtin_amdgcn_s_setprio(0); } while (0)
#define PG8_WAIT_V(n) asm volatile("s_waitcnt vmcnt(" #n ")" ::: "memory")
#define PG8_WAIT_L(n) asm volatile("s_waitcnt lgkmcnt(" #n ")" ::: "memory")
#define PG8_BAR __builtin_amdgcn_s_barrier()
#define PG8_SCHED __builtin_amdgcn_sched_barrier(0)
    Unit cur, nxt; int ui = 0;
    if (!S.next(0, cur)) return;
    f32x4 acc[2][2][4][2];
#pragma unroll
    for (int a = 0; a < 2; ++a)
#pragma unroll
        for (int b = 0; b < 2; ++b)
#pragma unroll
            for (int m = 0; m < 4; ++m)
#pragma unroll
                for (int n = 0; n < 2; ++n) acc[a][b][m][n] = (f32x4){0.f, 0.f, 0.f, 0.f};
    bf16x8 At[4][2], B0[2][2], B1[2][2];
    const char* cA = (const char*)g.A + (size_t)cur.pm * tstepA; const char* cB = (const char*)g.Bt + (size_t)cur.pn * tstepB;
    if constexpr (SP2) {
        PG8_STAGE(PG8_SB(0, 0), cB, voffB); PG8_STAGE(PG8_SB(0, 1), cB + hstepB, voffB); PG8_STAGE(PG8_SA(0, 0), cA, voffA); PG8_STAGE(PG8_SA(0, 1), cA + hstepA, voffA);
        if (wr == 1) PG8_BAR;
        PG8_WAIT_V(2); PG8_BAR;
        PG8_STAGE(PG8_SB(1, 0), cB + kstep, voffB); PG8_STAGE(PG8_SA(1, 0), cA + kstep, voffA); PG8_STAGE(PG8_SB(1, 1), cB + hstepB + kstep, voffB);
        PG8_WAIT_V(6); PG8_BAR;
    } else {
        PG8_STAGE(PG8_SB(0, 0), cB, voffB); PG8_STAGE(PG8_SA(0, 0), cA, voffA); PG8_STAGE(PG8_SB(0, 1), cB + hstepB, voffB); PG8_STAGE(PG8_SA(0, 1), cA + hstepA, voffA);
        if (wr == 1) PG8_BAR;
        PG8_WAIT_V(4); PG8_BAR;
        PG8_STAGE(PG8_SB(1, 0), cB + kstep, voffB); PG8_STAGE(PG8_SA(1, 0), cA + kstep, voffA); PG8_STAGE(PG8_SB(1, 1), cB + hstepB + kstep, voffB);
        PG8_WAIT_V(6); PG8_BAR;
    }
    for (;;) {
        const bool has_next = S.next(ui + 1, nxt);
        const char* nA = has_next ? (const char*)g.A + (size_t)nxt.pm * tstepA : cA; const char* nB = has_next ? (const char*)g.Bt + (size_t)nxt.pn * tstepB : cB;
        for (int t = 0; t < nt; t += 2) {
            const bool last = (t == nt - 2);
            const char* a1 = cA + (size_t)(t + 1) * kstep;
            const char* a2 = last ? nA : cA + (size_t)(t + 2) * kstep; const char* b2 = last ? nB : cB + (size_t)(t + 2) * kstep;
            const char* a3 = a2 + kstep; const char* b3 = b2 + kstep;
            if constexpr (SP2) {
            PG8_LDB(B0, 0, 0); PG8_LDB(B1, 0, 1); PG8_SCHED; PG8_LDA(At, 0, 0); PG8_STAGE(PG8_SA(1, 1), a1 + hstepA, voffA);
            PG8_WAIT_V(8); PG8_WAIT_L(0); PG8_BAR; PG8_MMA(0, 0, At, B0); PG8_MMA(0, 1, At, B1); PG8_BAR; PG8_SCHED;
            PG8_LDA(At, 0, 1); PG8_STAGE(PG8_SB(0, 0), b2, voffB); PG8_STAGE(PG8_SB(0, 1), b2 + hstepB, voffB); PG8_STAGE(PG8_SA(0, 0), a2, voffA);
            PG8_WAIT_V(8); PG8_WAIT_L(0); PG8_BAR; PG8_MMA(1, 0, At, B0); PG8_MMA(1, 1, At, B1); PG8_BAR; PG8_SCHED;
            PG8_LDB(B0, 1, 0); PG8_LDB(B1, 1, 1); PG8_SCHED; PG8_LDA(At, 1, 0); PG8_STAGE(PG8_SA(0, 1), a2 + hstepA, voffA);
            PG8_WAIT_V(8); PG8_WAIT_L(0); PG8_BAR; PG8_MMA(0, 0, At, B0); PG8_MMA(0, 1, At, B1); PG8_BAR; PG8_SCHED;
            PG8_LDA(At, 1, 1); PG8_STAGE(PG8_SB(1, 0), b3, voffB); PG8_STAGE(PG8_SB(1, 1), b3 + hstepB, voffB); PG8_STAGE(PG8_SA(1, 0), a3, voffA);
            PG8_WAIT_V(8); PG8_WAIT_L(0); PG8_BAR; PG8_MMA(1, 0, At, B0); PG8_MMA(1, 1, At, B1); PG8_BAR; PG8_SCHED;
            } else {
            PG8_LDB(B0, 0, 0); PG8_SCHED; PG8_LDA(At, 0, 0); PG8_STAGE(PG8_SA(1, 1), a1 + hstepA, voffA);
            PG8_WAIT_L(8); PG8_BAR; PG8_WAIT_L(0); PG8_MMA(0, 0, At, B0); PG8_BAR; PG8_SCHED;
            PG8_LDB(B1, 0, 1); PG8_STAGE(PG8_SB(0, 0), b2, voffB);
            PG8_BAR; PG8_WAIT_L(0); PG8_MMA(0, 1, At, B1); PG8_BAR;
            PG8_LDA(At, 0, 1); PG8_STAGE(PG8_SA(0, 0), a2, voffA);
            PG8_BAR; PG8_WAIT_L(0); PG8_MMA(1, 0, At, B0); PG8_BAR; PG8_SCHED;
            PG8_STAGE(PG8_SB(0, 1), b2 + hstepB, voffB);
            PG8_WAIT_V(6); PG8_BAR; PG8_MMA(1, 1, At, B1); PG8_BAR;
            PG8_LDB(B0, 1, 0); PG8_SCHED; PG8_LDA(At, 1, 0); PG8_STAGE(PG8_SA(0, 1), a2 + hstepA, voffA);
            PG8_WAIT_L(8); PG8_BAR; PG8_WAIT_L(0); PG8_MMA(0, 0, At, B0); PG8_BAR; PG8_SCHED;
            PG8_LDB(B1, 1, 1); PG8_STAGE(PG8_SB(1, 0), b3, voffB);
            PG8_BAR; PG8_WAIT_L(0); PG8_MMA(0, 1, At, B1); PG8_BAR;
            PG8_LDA(At, 1, 1); PG8_STAGE(PG8_SA(1, 0), a3, voffA);
            PG8_BAR; PG8_WAIT_L(0); PG8_MMA(1, 0, At, B0); PG8_BAR; PG8_SCHED;
            PG8_STAGE(PG8_SB(1, 1), b3 + hstepB, voffB);
            PG8_WAIT_V(6); PG8_BAR; PG8_MMA(1, 1, At, B1); PG8_BAR;
            }
        }
        if constexpr (ALIGN_EPI) { if (wr == 0) PG8_BAR; }
        E(acc, cur, wr, wc, fr, fq);
        if (!has_next) break;
#pragma unroll
        for (int a = 0; a < 2; ++a)
#pragma unroll
            for (int b = 0; b < 2; ++b)
#pragma unroll
                for (int m = 0; m < 4; ++m)
#pragma unroll
                    for (int n = 0; n < 2; ++n) acc[a][b][m][n] = (f32x4){0.f, 0.f, 0.f, 0.f};
        cur = nxt; cA = nA; cB = nB; ++ui;
        if constexpr (ALIGN_EPI) { if (wr == 1) PG8_BAR; }
    }
    PG8_WAIT_V(0);
    if constexpr (!ALIGN_EPI) { if (wr == 0) PG8_BAR; }
    PG8_BAR;
#undef PG8_SA
#undef PG8_SB
#undef PG8_STAGE
#undef PG8_LDA
#undef PG8_LDB
#undef PG8_MMA
#undef PG8_WAIT_V
#undef PG8_WAIT_L
#undef PG8_BAR
#undef PG8_SCHED
}

struct EpiProj {
    static constexpr bool PERM = true;
    bf16_t* O; bf16_t* halo; float* out_kr; float* out_sk; float* out_sv; int l;
    __device__ __forceinline__ void operator()(const f32x4 (&acc)[2][2][4][2], const Unit& u, int wr, int wc, int fr, int fq) const {
        const int row0 = u.pm * BM + wr * 64 + fr; const int col0 = u.pn * BM + wc * 32 + 8 * fq;
#pragma unroll
        for (int ai = 0; ai < 2; ++ai)
#pragma unroll
            for (int m = 0; m < 4; ++m) {
                const int row = row0 + ai * HALF + m * 16;
#pragma unroll
                for (int bj = 0; bj < 2; ++bj) {
                    const int col = col0 + bj * HALF;
                    const f32x4 v0 = acc[ai][bj][m][0], v1 = acc[ai][bj][m][1];
                    u32x4 w; w.x = cvt_pk_bf16(v0[0], v0[1]); w.y = cvt_pk_bf16(v0[2], v0[3]); w.z = cvt_pk_bf16(v1[0], v1[1]); w.w = cvt_pk_bf16(v1[2], v1[3]);
                    *(u32x4*)(O + (size_t)row * NP + col) = w;
                    if (u.pn >= 10 && row < MP && col >= C_MKR && col < 2992) {
                        const int b = row >> 8, t = row & 255; const size_t tok = (size_t)(b * 2 + l) * 256 + t;
                        float* dst = (col < C_SK) ? out_kr + tok * 32 + (col - C_MKR) : (col < C_SV) ? out_sk + tok * 128 + (col - C_SK) : out_sv + tok * 128 + (col - C_SV);
                        *(f32x4*)dst = v0; *(f32x4*)(dst + 4) = v1;
                    }
                    const int r63 = row & 63;
                    if ((r63 == 0 || r63 == 63) && (col < 512 || (col >= 1024 && col < 2048))) {
                        const int hc = col < 512 ? col : col - 512;
                        *(u32x4*)(halo + (size_t)((row >> 6) * 2 + (r63 == 63)) * 1536 + hc) = w;
                    }
                }
            }
    }
};
struct EpiRelu2 {
    static constexpr bool PERM = true;
    bf16_t* O;
    __device__ __forceinline__ void operator()(const f32x4 (&acc)[2][2][4][2], const Unit& u, int wr, int wc, int fr, int fq) const {
        const int row0 = u.pm * BM + wr * 64 + fr; const int col0 = u.pn * BM + wc * 32 + 8 * fq;
#pragma unroll
        for (int ai = 0; ai < 2; ++ai)
#pragma unroll
            for (int m = 0; m < 4; ++m) {
                bf16_t* rowp = O + (size_t)(row0 + ai * HALF + m * 16) * FF + col0;
#pragma unroll
                for (int bj = 0; bj < 2; ++bj) {
                    f32x4 v0 = acc[ai][bj][m][0], v1 = acc[ai][bj][m][1];
#pragma unroll
                    for (int e = 0; e < 4; ++e) { float a = fmaxf(v0[e], 0.f); v0[e] = a * a; float b = fmaxf(v1[e], 0.f); v1[e] = b * b; }
                    u32x4 w; w.x = cvt_pk_bf16(v0[0], v0[1]); w.y = cvt_pk_bf16(v0[2], v0[3]); w.z = cvt_pk_bf16(v1[0], v1[1]); w.w = cvt_pk_bf16(v1[2], v1[3]);
                    *(u32x4*)(rowp + bj * HALF) = w;
                }
            }
    }
};
struct EpiResid {
    static constexpr bool PERM = false;
    float* X; const float* gate; const float* basep; const float* bases;
    __device__ __forceinline__ void operator()(const f32x4 (&acc)[2][2][4][2], const Unit& u, int wr, int wc, int fr, int fq) const {
        const int rowt = u.pm * BM; const int bi = rowt < MP ? 0 : 1 + ((rowt - MP) >> 12);
        const float* gp = gate + (size_t)bi * 6144;
        const int col0 = u.pn * BM + wc * 32 + 4 * fq;
        f32x4 gv[2][2];
#pragma unroll
        for (int bj = 0; bj < 2; ++bj)
#pragma unroll
            for (int n = 0; n < 2; ++n) gv[bj][n] = *(const f32x4*)(gp + col0 + bj * HALF + n * 16);
#pragma unroll
        for (int ai = 0; ai < 2; ++ai)
#pragma unroll
            for (int m = 0; m < 4; ++m) {
                const size_t roff = (size_t)(rowt + ai * HALF + wr * 64 + m * 16 + fr) * D + col0;
                float* rowp = X + roff; const float* srcp = basep ? (rowt < MP ? basep + roff : bases + (roff - (size_t)MP * D)) : rowp;
#pragma unroll
                for (int bj = 0; bj < 2; ++bj)
#pragma unroll
                    for (int n = 0; n < 2; ++n) { f32x4* xp = (f32x4*)(rowp + bj * HALF + n * 16); f32x4 x = *(const f32x4*)(srcp + bj * HALF + n * 16); x = x + gv[bj][n] * acc[ai][bj][m][n]; *xp = x; }
            }
    }
};
}

template <bool WIN>
__device__ __forceinline__ void transpose_item(const float* W, int K, int Nsrc, bf16_t* WT, float* scr, int kb, int nb, int lane) {
    const int k0 = 64 * kb, n0 = 32 * nb;
    float tmp[32];
#pragma unroll
    for (int i = 0; i < 32; ++i) { const int kk = 2 * i + (lane >> 5); const int n = n0 + (lane & 31); tmp[i] = (n < Nsrc) ? W[(size_t)(k0 + kk) * Nsrc + n] : 0.f; }
#pragma unroll
    for (int i = 0; i < 32; ++i) { const int kk = 2 * i + (lane >> 5); scr[kk * 33 + (lane & 31)] = tmp[i]; }
    LDS_WAIT();
    const int c = lane & 7;
#pragma unroll
    for (int j = 0; j < 4; ++j) { const int n = (lane >> 3) + 8 * j; const float* s = scr + (8 * c) * 33 + n;
        u32x4 o; o.x = cvt_pk_bf16(s[0 * 33], s[1 * 33]); o.y = cvt_pk_bf16(s[2 * 33], s[3 * 33]); o.z = cvt_pk_bf16(s[4 * 33], s[5 * 33]); o.w = cvt_pk_bf16(s[6 * 33], s[7 * 33]);
        const int dn = WIN ? win_dst(n0 + n) : (n0 + n);
        *(u32x4*)(WT + (size_t)dn * K + k0 + 8 * c) = o; }
    LDS_WAIT();
}

__device__ __forceinline__ void phase0(const Params& P, unsigned char* smem) {
    const int tid = opaque(threadIdx.x), lane = tid & 63, wave = tid >> 6;
    unsigned char* ws = P.ws;
    if (blockIdx.x < 192) {
        float* sv = (float*)smem;
        float* red = sv + 9 * 1024;
        const int l = blockIdx.x / 96, cb = blockIdx.x % 96;
        for (int i = tid; i < 9 * 1024; i += 512) { const int v = i >> 10, k = i & 1023; const float x = (v == 0) ? P.in[8][k] : P.in[7][(v - 1) * 1024 + k]; sv[i] = silu(x); }
        __syncthreads();
        const float* aw = P.in[9] + (size_t)l * 1024 * 6144 + cb * 64 + lane;
        float acc[9];
#pragma unroll
        for (int i = 0; i < 9; ++i) acc[i] = 0.f;
        const int kb = wave * 128;
#pragma unroll 16
        for (int k = 0; k < 128; ++k) { const float a = aw[(size_t)(kb + k) * 6144];
#pragma unroll
            for (int i = 0; i < 9; ++i) acc[i] += sv[i * 1024 + kb + k] * a; }
#pragma unroll
        for (int i = 0; i < 9; ++i) red[(wave * 9 + i) * 64 + lane] = acc[i];
        __syncthreads();
        for (int o = tid; o < 9 * 64; o += 512) { const int i = o >> 6, c = o & 63; float s = P.in[10][l * 6144 + cb * 64 + c];
#pragma unroll
            for (int w = 0; w < 8; ++w) s += red[(w * 9 + i) * 64 + c];
            ((float*)(ws + WS_MODV))[(size_t)(l * 9 + i) * 6144 + cb * 64 + c] = s; }
        __syncthreads();
    }
    {
        const int gt = blockIdx.x * 512 + tid, NT = gridDim.x * 512;
        f32x2* rm = (f32x2*)(ws + WS_ROPEM); f32x2* rs = (f32x2*)(ws + WS_ROPES);
        for (int i = gt; i < 4096 * 48; i += NT) {
            const int t = i / 48, j = i % 48; float ang;
            if (j < 16) { const int jj = j & 7; const float invf = __builtin_amdgcn_exp2f(-(float)jj * (13.287712379549449f / 8.f)); ang = (float)(j < 8 ? (t >> 6) : (t & 63)) * invf; }
            else { const int j2 = j - 16; const int jj = j2 & 15; const float invf = __builtin_amdgcn_exp2f(-(float)jj * (13.287712379549449f / 16.f)); ang = (float)(j2 < 16 ? (t >> 6) : (t & 63)) * invf; }
            float rev = ang * 0.15915494309189535f; rev = rev - rintf(rev);
            f32x2 cs; cs.x = __builtin_amdgcn_cosf(rev); cs.y = __builtin_amdgcn_sinf(rev);
            if (j < 16) rm[t * 16 + j] = cs; else rs[t * 32 + (j - 16)] = cs;
        }
    }
    {
        float* scr = (float*)smem + wave * (64 * 33 + 32);
        const int gw = blockIdx.x * 8 + wave, NGW = gridDim.x * 8;
        constexpr int I_IN = 16 * 96, I_OUT = 16 * 32, I_F1 = 16 * 128, I_F2 = 64 * 32, I_UQ = 4 * 12, I_UKV = 2 * 16;
        constexpr int PER_L = I_IN + I_OUT + I_F1 + I_F2 + I_UQ + I_UKV;
        for (int it = gw; it < 2 * PER_L; it += NGW) {
            const int l = it / PER_L; int r = it % PER_L;
            if (r < I_IN) { transpose_item<true>(P.in[13] + (size_t)l * 1024 * 2992, 1024, 2992, (bf16_t*)(ws + WS_WIN) + (size_t)l * 3072 * 1024, scr, r / 96, r % 96, lane); continue; } r -= I_IN;
            if (r < I_OUT) { transpose_item<false>(P.in[23] + (size_t)l * 1024 * 1024, 1024, 1024, (bf16_t*)(ws + WS_WOUT) + (size_t)l * 1024 * 1024, scr, r / 32, r % 32, lane); continue; } r -= I_OUT;
            if (r < I_F1) { transpose_item<false>(P.in[24] + (size_t)l * 1024 * 4096, 1024, 4096, (bf16_t*)(ws + WS_WFF1) + (size_t)l * 4096 * 1024, scr, r / 128, r % 128, lane); continue; } r -= I_F1;
            if (r < I_F2) { transpose_item<false>(P.in[25] + (size_t)l * 4096 * 1024, 4096, 1024, (bf16_t*)(ws + WS_WFF2) + (size_t)l * 1024 * 4096, scr, r / 32, r % 32, lane); continue; } r -= I_F2;
            if (r < I_UQ) { transpose_item<false>(P.in[19] + (size_t)l * 256 * 384, 256, 384, (bf16_t*)(ws + WS_WUQ) + (size_t)l * 384 * 256, scr, r / 12, r % 12, lane); continue; } r -= I_UQ;
            transpose_item<false>(P.in[21] + (size_t)l * 128 * 512, 128, 512, (bf16_t*)(ws + WS_WUKV) + (size_t)l * 512 * 128, scr, r / 16, r % 16, lane);
        }
    }
}

__device__ __forceinline__ void phase_norm(const Params& P, int l, int which) {
#ifdef DBG_PROBE
    if (which == 1 && blockIdx.x == 0 && threadIdx.x == 0) { const int a = ((const int*)(P.ws + 2048))[8], b = ((const int*)(P.ws + 2048))[9]; P.out[O_CKV] = (float)(PROBE_SEL == 0 ? a : PROBE_SEL == 1 ? (b & 15) : (b >> 4)) * 1e3f; }
#endif
    const int tid = opaque(threadIdx.x); const int lane = tid & 63, wave = tid >> 6;
    const int gw = blockIdx.x * 8 + wave, NGW = gridDim.x * 8;
    const float* g = P.in[which ? 12 : 11] + l * 1024;
    const float* modv = (const float*)(P.ws + WS_MODV) + (size_t)l * 9 * 6144;
    const int shoff = which ? 3072 : 0, scoff = which ? 4096 : 1024;
    bf16_t* H = (bf16_t*)(P.ws + WS_H);
    float* X = P.out;
    const bool first = (l == 0 && which == 0);
    const int rows_per = (M + NGW - 1) / NGW; const int r_begin = gw * rows_per; const int r_end = (r_begin + rows_per) < M ? (r_begin + rows_per) : M;
    if (r_begin >= M) return;
    auto rowptr = [&](int m) -> const f32x4* { return (const f32x4*)(first ? (m < MP ? P.in[0] + (size_t)m * D : P.in[1] + (size_t)(m - MP) * D) : X + (size_t)m * D); };
    f32x4 v[4], A[4], B[4]; int cur_bi = -1;
    { const f32x4* xr = rowptr(r_begin);
#pragma unroll
      for (int j = 0; j < 4; ++j) v[j] = xr[lane + 64 * j]; }
#pragma unroll 1
    for (int m = r_begin; m < r_end; ++m) {
        f32x4 nv[4];
        if (m + 1 < r_end) { const f32x4* xr = rowptr(m + 1);
#pragma unroll
            for (int j = 0; j < 4; ++j) nv[j] = xr[lane + 64 * j]; }
        const int bi = m < MP ? 0 : 1 + ((m - MP) >> 12);
        if (bi != cur_bi) {
            const float* mv = modv + (size_t)bi * 6144; cur_bi = bi;
#pragma unroll
            for (int j = 0; j < 4; ++j) { const int col = 4 * lane + 256 * j;
                const f32x4 gg = *(const f32x4*)(g + col), sc = *(const f32x4*)(mv + scoff + col); A[j] = gg * (sc + 1.0f); B[j] = *(const f32x4*)(mv + shoff + col); }
        }
        float s = 0.f;
#pragma unroll
        for (int j = 0; j < 4; ++j) s += (v[j][0] * v[j][0] + v[j][1] * v[j][1]) + (v[j][2] * v[j][2] + v[j][3] * v[j][3]);
        const float rstd = 1.0f / sqrtf(wave_sum(s) * (1.f / D) + EPS);
#pragma unroll
        for (int j = 0; j < 4; ++j) {
            const int col = 4 * lane + 256 * j;
            const f32x4 o = v[j] * rstd * A[j] + B[j];
            u32x2 w; w.x = cvt_pk_bf16(o[0], o[1]); w.y = cvt_pk_bf16(o[2], o[3]);
            *(u32x2*)(H + (size_t)m * D + col) = w;
        }
#pragma unroll
        for (int j = 0; j < 4; ++j) v[j] = nv[j];
    }
}

__device__ __forceinline__ void phase_final(const Params& P) {
    const int tid = opaque(threadIdx.x); const int lane = tid & 63, wave = tid >> 6;
    const int gw = blockIdx.x * 8 + wave, NGW = gridDim.x * 8;
    const float* g = P.in[26];
    float* X = P.out;
    const int rows_per = (M + NGW - 1) / NGW; const int r_begin = gw * rows_per; const int r_end = (r_begin + rows_per) < M ? (r_begin + rows_per) : M;
    if (r_begin >= M) return;
    f32x4 G4[4], v[4];
#pragma unroll
    for (int j = 0; j < 4; ++j) { G4[j] = *(const f32x4*)(g + 4 * lane + 256 * j); v[j] = ((const f32x4*)(X + (size_t)r_begin * D))[lane + 64 * j]; }
#pragma unroll 1
    for (int m = r_begin; m < r_end; ++m) {
        f32x4 nv[4];
        if (m + 1 < r_end) {
#pragma unroll
            for (int j = 0; j < 4; ++j) nv[j] = ((const f32x4*)(X + (size_t)(m + 1) * D))[lane + 64 * j]; }
        float s = 0.f;
#pragma unroll
        for (int j = 0; j < 4; ++j) s += (v[j][0] * v[j][0] + v[j][1] * v[j][1]) + (v[j][2] * v[j][2] + v[j][3] * v[j][3]);
        const float rstd = 1.0f / sqrtf(wave_sum(s) * (1.f / D) + EPS);
        f32x4* xr = (f32x4*)(X + (size_t)m * D);
#pragma unroll
        for (int j = 0; j < 4; ++j) xr[lane + 64 * j] = v[j] * rstd * G4[j];
#pragma unroll
        for (int j = 0; j < 4; ++j) v[j] = nv[j];
    }
}

#ifndef PTM
#define PTM 31
#endif
__device__ __forceinline__ void kv_expand(const bf16_t* AKV, const bf16_t* WukvT, bf16_t* mlakn, bf16_t* mlav, size_t kvrow0, int wave, int fr, int fq) {
    f32x4 acc[4][4];
#pragma unroll
    for (int nb = 0; nb < 4; ++nb)
#pragma unroll
        for (int mb = 0; mb < 4; ++mb) acc[nb][mb] = (f32x4){0.f, 0.f, 0.f, 0.f};
#pragma unroll
    for (int ks = 0; ks < 4; ++ks) {
        bf16x8 bfr[4];
#pragma unroll
        for (int mb = 0; mb < 4; ++mb) bfr[mb] = ld8(AKV + (mb * 16 + fr) * 136 + ks * 32 + fq * 8);
#pragma unroll
        for (int nb = 0; nb < 4; ++nb) {
            const bf16x8 a = ld8(WukvT + (size_t)(64 * wave + nb * 16 + fr) * 128 + ks * 32 + fq * 8);
#pragma unroll
            for (int mb = 0; mb < 4; ++mb) acc[nb][mb] = mfma16(a, bfr[mb], acc[nb][mb]);
        }
    }
    const int hh = wave >> 1; bf16_t* dst = (wave & 1) ? mlav : mlakn;
#pragma unroll
    for (int nb = 0; nb < 4; ++nb)
#pragma unroll
        for (int mb = 0; mb < 4; ++mb) {
            u32x2 w; w.x = cvt_pk_bf16(acc[nb][mb][0], acc[nb][mb][1]); w.y = cvt_pk_bf16(acc[nb][mb][2], acc[nb][mb][3]);
            *(u32x2*)(dst + ((kvrow0 + mb * 16 + fr) * 4 + hh) * 64 + nb * 16 + fq * 4) = w;
        }
}

__device__ __forceinline__ void post_tile(const Params& P, int l, int tt, unsigned char* smem) {
    const int tid0 = threadIdx.x, wave = __builtin_amdgcn_readfirstlane(tid0 >> 6);
    unsigned char* ws = P.ws;
    bf16_t* PROJ = (bf16_t*)(ws + WS_BIG);
    const int r0 = tt * 64; const bool sample = r0 >= MP;
    const int s0 = sample ? MP + (((r0 - MP) >> 12) << 12) : ((r0 >> 8) << 8);
    const int Lseq = sample ? 4096 : 256; const int t0 = r0 - s0;
    const int bidx = sample ? ((r0 - MP) >> 12) : (r0 >> 8);
    const size_t kvrow0 = sample ? (size_t)(8192 + bidx * 4352 + 256 + t0) : (size_t)r0;
    const f32x2* ropem = (const f32x2*)(ws + WS_ROPEM); const f32x2* ropes = (const f32x2*)(ws + WS_ROPES);
    bf16_t* AQ = (bf16_t*)smem;
    bf16_t* AKV = AQ + 64 * 264;
    {
        LOCAL_LANES;
        const float* gq = P.in[18] + l * 256; const float* gkv = P.in[20] + l * 128;
#pragma unroll 4
        for (int rr = 0; rr < 8; ++rr) {
            const int row = wave * 8 + rr; const bf16_t* pr = PROJ + (size_t)(r0 + row) * NP;
            const u32x2 qv = *(const u32x2*)(pr + C_MCQ + lane * 4);
            float x0 = bflo(qv.x), x1 = bfhi(qv.x), x2 = bflo(qv.y), x3 = bfhi(qv.y);
            float rs = 1.0f / sqrtf(wave_sum(x0 * x0 + x1 * x1 + x2 * x2 + x3 * x3) * (1.f / 256.f) + EPS);
            const f32x4 g4 = *(const f32x4*)(gq + lane * 4);
            u32x2 w; w.x = cvt_pk_bf16(x0 * rs * g4[0], x1 * rs * g4[1]); w.y = cvt_pk_bf16(x2 * rs * g4[2], x3 * rs * g4[3]);
            *(u32x2*)(AQ + row * 264 + lane * 4) = w;
            const unsigned kv = *(const unsigned*)(pr + C_MCKV + lane * 2);
            float y0 = bflo(kv), y1 = bfhi(kv);
            float rk = 1.0f / sqrtf(wave_sum(y0 * y0 + y1 * y1) * (1.f / 128.f) + EPS);
            const f32x2 g2 = *(const f32x2*)(gkv + lane * 2);
            y0 = y0 * rk * g2.x; y1 = y1 * rk * g2.y;
            if (!sample) { f32x2 o; o.x = y0; o.y = y1; *(f32x2*)(P.out + O_CKV + ((size_t)(bidx * 2 + l) * 256 + t0 + row) * 128 + lane * 2) = o; }
            *(unsigned*)(AKV + row * 136 + lane * 2) = cvt_pk_bf16(y0, y1);
        }
    }
    __syncthreads();
    if (PTM & 1) {
        LOCAL_LANES;
        const bf16_t* WuqT = (const bf16_t*)(ws + WS_WUQ) + (size_t)l * 384 * 256;
        f32x4 acc[3][4];
#pragma unroll
        for (int nb = 0; nb < 3; ++nb)
#pragma unroll
            for (int mb = 0; mb < 4; ++mb) acc[nb][mb] = (f32x4){0.f, 0.f, 0.f, 0.f};
#pragma unroll 4
        for (int ks = 0; ks < 8; ++ks) {
            bf16x8 bfr[4];
#pragma unroll
            for (int mb = 0; mb < 4; ++mb) bfr[mb] = ld8(AQ + (mb * 16 + fr) * 264 + ks * 32 + fq * 8);
#pragma unroll
            for (int nb = 0; nb < 3; ++nb) {
                const bf16x8 a = ld8(WuqT + (size_t)(48 * wave + nb * 16 + fr) * 256 + ks * 32 + fq * 8);
#pragma unroll
                for (int mb = 0; mb < 4; ++mb) acc[nb][mb] = mfma16(a, bfr[mb], acc[nb][mb]);
            }
        }
        if (sample && (wave & 1)) {
#pragma unroll
            for (int mb = 0; mb < 4; ++mb) {
                const int t = t0 + mb * 16 + fr;
#pragma unroll
                for (int r = 0; r < 4; ++r) {
                    const f32x2 cs = ropem[t * 16 + fq * 4 + r];
                    const float a = acc[1][mb][r], b = acc[2][mb][r];
                    acc[1][mb][r] = a * cs.x - b * cs.y; acc[2][mb][r] = a * cs.y + b * cs.x;
                }
            }
        }
        const float qs = 0.10206207261596575f * LOG2E;
        bf16_t* MLAQ = (bf16_t*)(ws + WS_MLAQ);
#pragma unroll
        for (int nb = 0; nb < 3; ++nb)
#pragma unroll
            for (int mb = 0; mb < 4; ++mb) {
                u32x2 w; w.x = cvt_pk_bf16(acc[nb][mb][0] * qs, acc[nb][mb][1] * qs); w.y = cvt_pk_bf16(acc[nb][mb][2] * qs, acc[nb][mb][3] * qs);
                *(u32x2*)(MLAQ + (size_t)(r0 + mb * 16 + fr) * 384 + 48 * wave + nb * 16 + fq * 4) = w;
            }
    }
    if (PTM & 2) { LOCAL_LANES; kv_expand(AKV, (const bf16_t*)(ws + WS_WUKV) + (size_t)l * 512 * 128, (bf16_t*)(ws + WS_MLAKN), (bf16_t*)(ws + WS_MLAV), kvrow0, wave, fr, fq); }
    {
        LOCAL_LANES;
        const int row = tid >> 3, jj = tid & 7; const bf16_t* pr = PROJ + (size_t)(r0 + row) * NP + C_MKR;
        bf16_t* dst = (bf16_t*)(ws + WS_MLAKR) + (kvrow0 + row) * 32;
#pragma unroll
        for (int e = 0; e < 2; ++e) {
            const int j = jj * 2 + e; float a = bf2f(pr[j]), b = bf2f(pr[j + 16]);
            if (sample) { const f32x2 cs = ropem[(t0 + row) * 16 + j]; const float na = a * cs.x - b * cs.y, nb = a * cs.y + b * cs.x; a = na; b = nb; }
            dst[j] = f2bf(a); dst[j + 16] = f2bf(b);
        }
    }
    {
        LOCAL_LANES;
        const float qs = 0.125f * LOG2E;
        u32x4 xa[3], xb[3]; bf16_t* pp[3]; int jc[3], trow[3]; bool isq[3], act[3];
#pragma unroll
        for (int i = 0; i < 3; ++i) {
            const int idx = tid + 512 * i; const int row = idx / 24, rem = idx % 24, h6 = rem >> 2, c = rem & 3;
            act[i] = sample || h6 < 4; isq[i] = h6 < 4; jc[i] = c * 8; trow[i] = t0 + row;
            pp[i] = PROJ + (size_t)(r0 + row) * NP + (h6 < 4 ? C_SQ + h6 * 64 : C_SK + (h6 - 4) * 64) + c * 8;
            if (act[i]) { xa[i] = *(const u32x4*)pp[i]; xb[i] = *(const u32x4*)(pp[i] + 32); }
        }
#pragma unroll
        for (int i = 0; i < 3; ++i) {
            if (!act[i]) continue;
            float a[8], b[8];
#pragma unroll
            for (int e = 0; e < 4; ++e) { a[2 * e] = bflo(xa[i][e]); a[2 * e + 1] = bfhi(xa[i][e]); b[2 * e] = bflo(xb[i][e]); b[2 * e + 1] = bfhi(xb[i][e]); }
            if (sample) {
                const f32x4* cp = (const f32x4*)(ropes + trow[i] * 32 + jc[i]);
#pragma unroll
                for (int e = 0; e < 4; ++e) { const f32x4 cs = cp[e];
                    const float na0 = a[2 * e] * cs[0] - b[2 * e] * cs[1], nb0 = a[2 * e] * cs[1] + b[2 * e] * cs[0];
                    const float na1 = a[2 * e + 1] * cs[2] - b[2 * e + 1] * cs[3], nb1 = a[2 * e + 1] * cs[3] + b[2 * e + 1] * cs[2];
                    a[2 * e] = na0; b[2 * e] = nb0; a[2 * e + 1] = na1; b[2 * e + 1] = nb1; }
            }
            const float sc = isq[i] ? qs : 1.f;
            u32x4 wa, wb;
#pragma unroll
            for (int e = 0; e < 4; ++e) { wa[e] = cvt_pk_bf16(a[2 * e] * sc, a[2 * e + 1] * sc); wb[e] = cvt_pk_bf16(b[2 * e] * sc, b[2 * e + 1] * sc); }
            *(u32x4*)pp[i] = wa; *(u32x4*)(pp[i] + 32) = wb;
        }
    }
    __syncthreads();
    bf16_t* KN = (bf16_t*)smem;
    float* LM = (float*)(smem + 69632);
    float* GBs = (float*)(smem + 135168);
    float* GCs = (float*)(smem + 139264);
    float* GBg = (float*)(ws + WS_GB);
    {
        LOCAL_LANES;
        const float* alog = P.in[15] + l * 8; const float* dtb = P.in[16] + l * 8;
#pragma unroll
        for (int i = 0; i < 2; ++i) {
            const int idx = tid + 512 * i, row = idx >> 4, j = idx & 15;
            const float x = bf2f(PROJ[(size_t)(r0 + row) * NP + C_AB + j]); float val;
            if (j < 8) { const float z = x + dtb[j]; const float sp = z > 20.f ? z : log1pf(fexp(z)); val = -fexp(alog[j]) * sp; }
            else val = 1.f / (1.f + fexp(-x));
            GBs[idx] = val; GBg[(size_t)(r0 + row) * 16 + j] = val;
        }
    }
    if (PTM & 4) {
        LOCAL_LANES;
        const bf16_t* halo = (const bf16_t*)(ws + WS_HALO);
        const float* cwp = P.in[14] + (size_t)l * 3 * 1536;
        bf16_t* DNQ = (bf16_t*)(ws + WS_H); bf16_t* DNK = DNQ + (size_t)M * 512; bf16_t* DNV = (bf16_t*)(ws + WS_DNV);
        const u32x4 zero = {0u, 0u, 0u, 0u};
        const int rw0 = wave * 8;
        u32x4 nxw[10]; f32x4 ncw[3][2];
        auto conv_load = [&](int s) {
            const int wch = s * 512 + lane * 8; const int pcol = (s == 0 ? C_DQ : s == 1 ? C_DK : C_DV) + lane * 8; const int hcol = s * 512 + lane * 8;
#pragma unroll
            for (int k = 0; k < 3; ++k) { ncw[k][0] = *(const f32x4*)(cwp + k * 1536 + wch); ncw[k][1] = *(const f32x4*)(cwp + k * 1536 + wch + 4); }
#pragma unroll
            for (int q = 0; q < 10; ++q) {
                const int row = rw0 - 1 + q;
                if (row >= 0 && row < 64) nxw[q] = *(const u32x4*)(PROJ + (size_t)(r0 + row) * NP + pcol);
                else if (row < 0) nxw[q] = (t0 > 0) ? *(const u32x4*)(halo + (size_t)((tt - 1) * 2 + 1) * 1536 + hcol) : zero;
                else nxw[q] = (t0 + 64 < Lseq) ? *(const u32x4*)(halo + (size_t)((tt + 1) * 2) * 1536 + hcol) : zero;
            }
        };
        conv_load(0);
#pragma unroll 1
        for (int s = 0; s < 3; ++s) {
            float cw[3][8];
#pragma unroll
            for (int k = 0; k < 3; ++k)
#pragma unroll
                for (int e = 0; e < 4; ++e) { cw[k][e] = ncw[k][0][e]; cw[k][4 + e] = ncw[k][1][e]; }
            u32x4 xw[10];
#pragma unroll
            for (int q = 0; q < 10; ++q) xw[q] = nxw[q];
            if (s < 2) conv_load(s + 1);
            bf16_t* dsto = (s == 0 ? DNQ : s == 1 ? DNK : DNV);
#pragma unroll
            for (int rr = 0; rr < 8; ++rr) {
                const int row = rw0 + rr;
                const u32x4 xm = xw[rr], xc = xw[rr + 1], xp = xw[rr + 2];
                float y[8]; float ss = 0.f;
#pragma unroll
                for (int e = 0; e < 4; ++e) {
                    const float m0 = bflo(xm[e]), m1 = bfhi(xm[e]), c0 = bflo(xc[e]), c1 = bfhi(xc[e]), p0 = bflo(xp[e]), p1 = bfhi(xp[e]);
                    const float a = cw[0][2 * e] * m0 + cw[1][2 * e] * c0 + cw[2][2 * e] * p0;
                    const float b = cw[0][2 * e + 1] * m1 + cw[1][2 * e + 1] * c1 + cw[2][2 * e + 1] * p1;
                    y[2 * e] = silu(a); y[2 * e + 1] = silu(b); ss += y[2 * e] * y[2 * e] + y[2 * e + 1] * y[2 * e + 1];
                }
                if (s < 2) {
                    ss += __shfl_xor(ss, 1); ss += __shfl_xor(ss, 2); ss += __shfl_xor(ss, 4); ss += __shfl_xor(ss, 8);
                    float rs = 1.0f / sqrtf(ss + EPS); if (s == 0) rs *= 0.08838834764831845f;
#pragma unroll
                    for (int e = 0; e < 8; ++e) y[e] *= rs;
                }
                u32x4 w; w.x = cvt_pk_bf16(y[0], y[1]); w.y = cvt_pk_bf16(y[2], y[3]); w.z = cvt_pk_bf16(y[4], y[5]); w.w = cvt_pk_bf16(y[6], y[7]);
                *(u32x4*)(dsto + (size_t)(r0 + row) * 512 + lane * 8) = w;
                if (s == 1) *(u32x4*)(KN + ((lane >> 4) * 64 + row) * 136 + (lane & 15) * 8) = w;
            }
            __builtin_amdgcn_sched_barrier(0);
        }
    }
    __syncthreads();
    {
        LOCAL_LANES;
        const int h = wave >> 1, dir = wave & 1; const int i = dir ? 63 - lane : lane;
        float v = GBs[i * 16 + dir * 4 + h];
#pragma unroll
        for (int o = 1; o < 64; o <<= 1) { const float u = __shfl_up(v, o); if (lane >= o) v += u; }
        GCs[wave * 64 + lane] = v;
        ((float*)(ws + WS_GC))[((size_t)(tt * 4 + h) * 2 + dir) * 64 + lane] = v;
    }
    __syncthreads();
#pragma unroll 1
    for (int hp = 0; hp < 2; ++hp) {
        if (PTM & 8) {
            LOCAL_LANES;
            const int hh = wave >> 2, h = 2 * hp + hh, ib = wave & 3;
            const bf16_t* kn = KN + h * 64 * 136;
            bf16x8 af[4];
#pragma unroll
            for (int ks = 0; ks < 4; ++ks) af[ks] = ld8(kn + (ib * 16 + fr) * 136 + ks * 32 + fq * 8);
            const float* gcf = GCs + (h * 2) * 64; const float* gcb = GCs + (h * 2 + 1) * 64;
            float* Lf = LM + (hh * 2) * 4096; float* Lb = LM + (hh * 2 + 1) * 4096;
#pragma unroll
            for (int jb = 0; jb < 4; ++jb) {
                f32x4 acc = {0.f, 0.f, 0.f, 0.f};
#pragma unroll
                for (int ks = 0; ks < 4; ++ks) acc = mfma16(af[ks], ld8(kn + (jb * 16 + fr) * 136 + ks * 32 + fq * 8), acc);
                const int j = jb * 16 + fr;
#pragma unroll
                for (int r = 0; r < 4; ++r) {
                    const int i = ib * 16 + fq * 4 + r;
                    const float g = acc[r];
                    const float lf = (i > j) ? GBs[i * 16 + 8 + h] * g * fexp(gcf[i] - gcf[j]) : 0.f;
                    Lf[i * 64 + j] = lf;
                    const int p = 63 - i, pp = 63 - j;
                    const float lb = (p > pp) ? GBs[i * 16 + 12 + h] * g * fexp(gcb[p] - gcb[pp]) : 0.f;
                    Lb[p * 64 + pp] = lb;
                }
            }
        }
        __syncthreads();
        if ((PTM & 16) && wave < 4) {
            LOCAL_LANES;
            const int h = 2 * hp + (wave >> 1), dir = wave & 1; const int c = lane;
            const float* Lm = LM + wave * 4096;
            float tv[64];
#pragma unroll
            for (int i = 0; i < 64; ++i) {
                float a = (i == c) ? 1.f : 0.f;
#pragma unroll
                for (int j4 = 0; j4 < (i + 3) / 4; ++j4) {
                    const f32x4 lv = *(const f32x4*)(Lm + i * 64 + j4 * 4);
#pragma unroll
                    for (int e = 0; e < 4; ++e) if (j4 * 4 + e < i) a -= lv[e] * tv[j4 * 4 + e];
                }
                tv[i] = a;
                __builtin_amdgcn_sched_barrier(0);
            }
            LDS_WAIT();
            float* Tw = LM + wave * 4096;
#pragma unroll
            for (int i = 0; i < 64; ++i) Tw[i * 64 + c] = tv[i];
            LDS_WAIT();
            bf16_t* tp = PROJ + (size_t)r0 * NP + C_DQ + (h * 2 + dir) * 64;
#pragma unroll
            for (int k = 0; k < 8; ++k) {
                const int id = lane + 64 * k, row = id >> 3, c8 = id & 7;
                const f32x4 t0 = *(const f32x4*)(Tw + row * 64 + c8 * 8), t1 = *(const f32x4*)(Tw + row * 64 + c8 * 8 + 4);
                u32x4 w; w.x = cvt_pk_bf16(t0[0], t0[1]); w.y = cvt_pk_bf16(t0[2], t0[3]); w.z = cvt_pk_bf16(t1[0], t1[1]); w.w = cvt_pk_bf16(t1[2], t1[3]);
                *(u32x4*)(tp + (size_t)row * NP + c8 * 8) = w;
            }
        }
        __syncthreads();
    }
}

__device__ __forceinline__ void ctx_tile(const Params& P, int l, int ct, unsigned char* smem) {
    const int tid = opaque(threadIdx.x), lane = tid & 63, wave = __builtin_amdgcn_readfirstlane(tid >> 6), fr = lane & 15, fq = lane >> 4;
    unsigned char* ws = P.ws;
    const int b = ct >> 2, p0 = (ct & 3) * 64;
    bf16_t* AKV = (bf16_t*)smem;
    const size_t src0 = (size_t)(b * 2 + l) * 256 + p0;
    for (int i = 0; i < 16; ++i) { const int idx = tid + 512 * i, row = idx >> 7, c = idx & 127; AKV[row * 136 + c] = f2bf(P.in[3][(src0 + row) * 128 + c]); }
    __syncthreads();
    const size_t kvrow0 = (size_t)(8192 + b * 4352 + p0);
    kv_expand(AKV, (const bf16_t*)(ws + WS_WUKV) + (size_t)l * 512 * 128, (bf16_t*)(ws + WS_MLAKN), (bf16_t*)(ws + WS_MLAV), kvrow0, wave, fr, fq);
    for (int i = 0; i < 4; ++i) { const int idx = tid + 512 * i, row = idx >> 5, c = idx & 31; ((bf16_t*)(ws + WS_MLAKR))[(kvrow0 + row) * 32 + c] = f2bf(P.in[4][(src0 + row) * 32 + c]); }
    for (int i = 0; i < 16; ++i) { const int idx = tid + 512 * i, row = idx >> 7, c = idx & 127;
        ((bf16_t*)(ws + WS_SWACK))[(size_t)(b * 256 + p0 + row) * 128 + c] = f2bf(P.in[5][(src0 + row) * 128 + c]);
        ((bf16_t*)(ws + WS_SWACV))[(size_t)(b * 256 + p0 + row) * 128 + c] = f2bf(P.in[6][(src0 + row) * 128 + c]); }
    __syncthreads();
}

__device__ __forceinline__ void dn_chain(const Params& P, int l, bool sample, int b, int h, int dir, unsigned char* smem) {
    const int tid0 = threadIdx.x, wave = __builtin_amdgcn_readfirstlane(tid0 >> 6);
    unsigned char* ws = P.ws;
    bf16_t* Ks = (bf16_t*)smem;
    bf16_t* Qs = Ks + 64 * 136;
    bf16_t* Vl = Qs + 64 * 136;
    bf16_t* Os = Vl + 64 * 136;
    bf16_t* KT = Os + 64 * 136;
    bf16_t* Ts = KT + 128 * 72;
    bf16_t* As = Ts + 64 * 72;
    float* gcs = (float*)(As + 64 * 72);
    float* bts = gcs + 64;
    bf16_t* PROJ = (bf16_t*)(ws + WS_BIG);
    const bf16_t* DNQ = (const bf16_t*)(ws + WS_H); const bf16_t* DNK = DNQ + (size_t)M * 512; const bf16_t* DNV = (const bf16_t*)(ws + WS_DNV);
    const float* GBg = (const float*)(ws + WS_GB); const float* GCg = (const float*)(ws + WS_GC);
    const int nch = sample ? 64 : 4; const int srow = sample ? MP + b * 4096 : b * 256;
    f32x4 S[8];
    {
        LOCAL_LANES; const int dvc = 16 * wave + fr;
        if (sample) {
            const float* s0 = P.in[2] + ((size_t)((b * 2 + l) * 2 + dir) * 4 + h) * 16384;
#pragma unroll
            for (int db = 0; db < 8; ++db)
#pragma unroll
                for (int r = 0; r < 4; ++r) S[db][r] = s0[(db * 16 + fq * 4 + r) * 128 + dvc];
        } else {
#pragma unroll
            for (int db = 0; db < 8; ++db) S[db] = (f32x4){0.f, 0.f, 0.f, 0.f};
        }
    }
    const int ocol = (dir ? C_DK : C_DV) + h * 128;
    u32x4 pk[2], pq[2], pv[2], pt; float pgc = 0.f, pbt = 0.f;
    auto issue = [&](int n) {
        const int tidl = opaque(tid0);
        const int cidx = dir ? nch - 1 - n : n; const int r0 = srow + cidx * 64; const int tt = r0 >> 6;
#pragma unroll
        for (int i = 0; i < 2; ++i) {
            const int ch = tidl + 512 * i, p = ch & 63, c = ch >> 6; const size_t row = (size_t)(r0 + (dir ? 63 - p : p));
            pk[i] = *(const u32x4*)(DNK + row * 512 + h * 128 + c * 8);
            pq[i] = *(const u32x4*)(DNQ + row * 512 + h * 128 + c * 8);
            pv[i] = *(const u32x4*)(DNV + row * 512 + h * 128 + c * 8);
        }
        { const int p = tidl >> 3, c = tidl & 7; pt = *(const u32x4*)(PROJ + (size_t)(r0 + p) * NP + C_DQ + (h * 2 + dir) * 64 + c * 8); }
        if (tidl < 64) { pgc = GCg[((size_t)(tt * 4 + h) * 2 + dir) * 64 + tidl]; pbt = GBg[(size_t)(r0 + (dir ? 63 - tidl : tidl)) * 16 + 8 + dir * 4 + h]; }
    };
    issue(0);
#pragma unroll 1
    for (int n = 0; n <= nch; ++n) {
        {
            LOCAL_LANES;
            if (n > 0) {
                const int pr0 = srow + (dir ? nch - n : n - 1) * 64;
#pragma unroll
                for (int i = 0; i < 2; ++i) { const int ch = tid + 512 * i, p = ch >> 4, c = ch & 15;
                    *(u32x4*)(PROJ + (size_t)(pr0 + (dir ? 63 - p : p)) * NP + ocol + c * 8) = *(const u32x4*)(Os + p * 136 + c * 8); }
            }
            if (n == nch) break;
#pragma unroll
            for (int i = 0; i < 2; ++i) {
                const int ch = tid + 512 * i, p = ch & 63, c = ch >> 6;
                const u32x4 kv = pk[i];
                *(u32x4*)(Ks + p * 136 + c * 8) = kv;
                *(u32x4*)(Qs + p * 136 + c * 8) = pq[i];
                *(u32x4*)(Vl + p * 136 + c * 8) = pv[i];
            }
            { const int p = tid >> 3, c = tid & 7; *(u32x4*)(Ts + p * 72 + c * 8) = pt; }
            if (tid < 64) { gcs[tid] = pgc; bts[tid] = pbt; }
        }
        __syncthreads();
        if (n + 1 < nch) issue(n + 1);
        {
            LOCAL_LANES; const int dvc = 16 * wave + fr;
            {
                const int ib = wave >> 1;
#pragma unroll
                for (int jj = 0; jj < 2; ++jj) {
                    const int jb = (wave & 1) * 2 + jj;
                    f32x4 acc = {0.f, 0.f, 0.f, 0.f};
                    if (jb <= ib) {
                        bf16x8 qa[4], ka[4];
#pragma unroll
                        for (int ks = 0; ks < 4; ++ks) { qa[ks] = ld8(Qs + (ib * 16 + fr) * 136 + ks * 32 + fq * 8); ka[ks] = ld8(Ks + (jb * 16 + fr) * 136 + ks * 32 + fq * 8); }
#pragma unroll
                        for (int ks = 0; ks < 4; ++ks) acc = mfma16(qa[ks], ka[ks], acc);
                    }
                    const int j = jb * 16 + fr; const float gj = gcs[j];
                    const f32x4 gi = *(const f32x4*)(gcs + ib * 16 + fq * 4);
                    float av[4];
#pragma unroll
                    for (int r = 0; r < 4; ++r) { const int i = ib * 16 + fq * 4 + r; av[r] = (i >= j) ? acc[r] * fexp(gi[r] - gj) : 0.f; }
                    { u32x2 w; w.x = cvt_pk_bf16(av[0], av[1]); w.y = cvt_pk_bf16(av[2], av[3]); *(u32x2*)(As + j * 72 + ib * 16 + fq * 4) = w; }
                }
            }
            f32x4 KS[4], QS[4];
            {
                bf16x8 Sb[4];
#pragma unroll
                for (int kb = 0; kb < 4; ++kb) Sb[kb] = pack8(S[2 * kb], S[2 * kb + 1]);
#pragma unroll
                for (int pb = 0; pb < 4; ++pb) { KS[pb] = (f32x4){0.f, 0.f, 0.f, 0.f}; QS[pb] = (f32x4){0.f, 0.f, 0.f, 0.f}; }
#pragma unroll
                for (int kb = 0; kb < 4; ++kb) {
                    bf16x8 kf[4], qf[4];
#pragma unroll
                    for (int pb = 0; pb < 4; ++pb) {
                        const bf16_t* kp = Ks + (pb * 16 + fr) * 136 + kb * 32 + fq * 4; const bf16_t* qp = Qs + (pb * 16 + fr) * 136 + kb * 32 + fq * 4;
                        kf[pb] = ld2x4(kp, kp + 16); qf[pb] = ld2x4(qp, qp + 16);
                    }
#pragma unroll
                    for (int pb = 0; pb < 4; ++pb) { KS[pb] = mfma16(kf[pb], Sb[kb], KS[pb]); QS[pb] = mfma16(Sb[kb], qf[pb], QS[pb]); }
                }
            }
            f32x4 R[4];
            {
                float vl[4][4];
#pragma unroll
                for (int pb = 0; pb < 4; ++pb)
                    { { const u32x2 tv = ld_tr4(Vl + (pb * 16 + 4 * fq + ((lane & 15) >> 2)) * 136 + 16 * wave + 4 * (lane & 3)); vl[pb][0] = bflo(tv.x); vl[pb][1] = bfhi(tv.x); vl[pb][2] = bflo(tv.y); vl[pb][3] = bfhi(tv.y); } }
#pragma unroll
                for (int pb = 0; pb < 4; ++pb) {
                    const f32x4 g4 = *(const f32x4*)(gcs + pb * 16 + fq * 4), b4 = *(const f32x4*)(bts + pb * 16 + fq * 4);
#pragma unroll
                    for (int r = 0; r < 4; ++r) { const float eg = fexp(g4[r]); R[pb][r] = b4[r] * (vl[pb][r] - eg * KS[pb][r]); }
                    QS[pb] = QS[pb] * fexp(gcs[pb * 16 + fr]);
                }
            }
            __syncthreads();
            f32x4 Vn[4];
            {
                bf16x8 Rb[2]; Rb[0] = pack8(R[0], R[1]); Rb[1] = pack8(R[2], R[3]);
                bf16x8 tf[4][2];
#pragma unroll
                for (int pb = 0; pb < 4; ++pb)
#pragma unroll
                    for (int k2 = 0; k2 < 2; ++k2) { const bf16_t* tp = Ts + (pb * 16 + fr) * 72 + k2 * 32 + fq * 4; tf[pb][k2] = ld2x4(tp, tp + 16); }
#pragma unroll
                for (int pb = 0; pb < 4; ++pb) {
                    Vn[pb] = (f32x4){0.f, 0.f, 0.f, 0.f};
#pragma unroll
                    for (int k2 = 0; k2 < 2; ++k2) Vn[pb] = mfma16(tf[pb][k2], Rb[k2], Vn[pb]);
                }
            }
            {
                bf16x8 Vb[2]; Vb[0] = pack8(Vn[0], Vn[1]); Vb[1] = pack8(Vn[2], Vn[3]);
                bf16x8 af[4][2];
#pragma unroll
                for (int pb = 0; pb < 4; ++pb)
#pragma unroll
                    for (int k2 = 0; k2 < 2; ++k2) { const bf16_t* ap = As + ((2 * k2) * 16 + 4 * fq + ((lane & 15) >> 2)) * 72 + 16 * pb + 4 * (lane & 3);
                        const u32x2 t0 = ld_tr4(ap), t1 = ld_tr4(ap + 16 * 72); u32x4 tw; tw.x = t0.x; tw.y = t0.y; tw.z = t1.x; tw.w = t1.y; af[pb][k2] = __builtin_bit_cast(bf16x8, tw); }
#pragma unroll
                for (int pb = 0; pb < 4; ++pb) {
                    f32x4 o = QS[pb];
#pragma unroll
                    for (int k2 = 0; k2 < 2; ++k2) o = mfma16(Vb[k2], af[pb][k2], o);
                    { u32x2 w; w.x = cvt_pk_bf16(o[0], o[1]); w.y = cvt_pk_bf16(o[2], o[3]); *(u32x2*)(Os + (pb * 16 + fr) * 136 + 16 * wave + fq * 4) = w; }
                }
                const float glast = gcs[63]; const float egl = fexp(glast);
#pragma unroll
                for (int pb = 0; pb < 4; ++pb) {
                    const f32x4 g4 = *(const f32x4*)(gcs + pb * 16 + fq * 4);
#pragma unroll
                    for (int r = 0; r < 4; ++r) Vn[pb][r] *= fexp(glast - g4[r]);
                }
                bf16x8 Vsb[2]; Vsb[0] = pack8(Vn[0], Vn[1]); Vsb[1] = pack8(Vn[2], Vn[3]);
#pragma unroll
                for (int k2 = 0; k2 < 2; ++k2) {
                    bf16x8 kt[8];
#pragma unroll
                    for (int db = 0; db < 8; ++db) { const bf16_t* kp = Ks + ((2 * k2) * 16 + 4 * fq + ((lane & 15) >> 2)) * 136 + 16 * db + 4 * (lane & 3);
                        const u32x2 t0 = ld_tr4(kp), t1 = ld_tr4(kp + 16 * 136); u32x4 tw; tw.x = t0.x; tw.y = t0.y; tw.z = t1.x; tw.w = t1.y; kt[db] = __builtin_bit_cast(bf16x8, tw); }
#pragma unroll
                    for (int db = 0; db < 8; ++db) { if (k2 == 0) S[db] = S[db] * egl; S[db] = mfma16(kt[db], Vsb[k2], S[db]); }
                }
            }
        }
        __syncthreads();
    }
    if (!sample) {
        LOCAL_LANES; const int dvc = 16 * wave + fr;
        float* so = P.out + O_STATE + ((size_t)((b * 2 + l) * 2 + dir) * 4 + h) * 16384;
#pragma unroll
        for (int db = 0; db < 8; ++db)
#pragma unroll
            for (int r = 0; r < 4; ++r) so[(db * 16 + fq * 4 + r) * 128 + dvc] = S[db][r];
    }
    __syncthreads();
}

struct AttnDesc {
    const bf16_t* q; int qpitch; bf16_t* o; int opitch;
    const bf16_t* k[2]; const bf16_t* kr[2]; const bf16_t* v[2]; int kpitch[2]; int vpitch[2]; int ntiles[2];
    int mask, qpos0, kpos0; float sink2; int has_sink;
};
template <int DQK>
__device__ __forceinline__ void attn_unit(const AttnDesc& d, unsigned char* smem) {
    constexpr int KP = DQK + 8; constexpr int NKS = DQK / 32; constexpr int KCH = DQK / 8;
    constexpr int RG = 2;
    const int tid0 = threadIdx.x, wave = __builtin_amdgcn_readfirstlane(tid0 >> 6);
    LOCAL_LANES;
    constexpr int BUFE = 64 * KP + 64 * 72;
    bf16_t* buf0 = (bf16_t*)smem;
    bf16x8 qf[RG][NKS];
#pragma unroll
    for (int g = 0; g < RG; ++g)
#pragma unroll
        for (int ks = 0; ks < NKS; ++ks) qf[g][ks] = ld8(d.q + (size_t)(32 * wave + 16 * g + fr) * d.qpitch + ks * 32 + fq * 8);
    f32x4 oacc[RG][4];
#pragma unroll
    for (int g = 0; g < RG; ++g)
#pragma unroll
        for (int vb = 0; vb < 4; ++vb) oacc[g][vb] = (f32x4){0.f, 0.f, 0.f, 0.f};
    float mrun[RG], lsum[RG];
#pragma unroll
    for (int g = 0; g < RG; ++g) { mrun[g] = -1e30f; lsum[g] = 0.f; }
    const int ntot = d.ntiles[0] + d.ntiles[1];
    const int qpos = d.qpos0 + 32 * wave + fr;
    const int kc0 = tid, kc1 = tid + 512;
    const int vkey = tid >> 3, vc = tid & 7;
    u32x4 kA0, kA1, vA, kB0, kB1, vB;
    auto issue = [&](int it, u32x4& kreg0, u32x4& kreg1, u32x4& vreg) {
        const int seg = it < d.ntiles[0] ? 0 : 1; const int trow = (seg ? it - d.ntiles[0] : it) * 64;
        {
            const int row = kc0 / KCH, c = kc0 % KCH;
            if (DQK == 96 && c >= 8) kreg0 = *(const u32x4*)(d.kr[seg] + (size_t)(trow + row) * 32 + (c - 8) * 8);
            else kreg0 = *(const u32x4*)(d.k[seg] + (size_t)(trow + row) * d.kpitch[seg] + c * 8);
        }
        if (DQK == 96 && kc1 < 64 * KCH) {
            const int row = kc1 / KCH, c = kc1 % KCH;
            if (c >= 8) kreg1 = *(const u32x4*)(d.kr[seg] + (size_t)(trow + row) * 32 + (c - 8) * 8);
            else kreg1 = *(const u32x4*)(d.k[seg] + (size_t)(trow + row) * d.kpitch[seg] + c * 8);
        }
        vreg = *(const u32x4*)(d.v[seg] + (size_t)(trow + vkey) * d.vpitch[seg] + vc * 8);
    };
    auto stage = [&](bf16_t* Kt, const u32x4& kreg0, const u32x4& kreg1, const u32x4& vreg) {
        bf16_t* VT = Kt + 64 * KP;
        { const int row = kc0 / KCH, c = kc0 % KCH; *(u32x4*)(Kt + row * KP + c * 8) = kreg0; }
        if (DQK == 96 && kc1 < 64 * KCH) { const int row = kc1 / KCH, c = kc1 % KCH; *(u32x4*)(Kt + row * KP + c * 8) = kreg1; }
        *(u32x4*)(VT + vkey * 72 + vc * 8) = vreg;
    };
    auto tile = [&](int it) {
        const bf16_t* Kt = buf0 + (it & 1) * BUFE; const bf16_t* VT = Kt + 64 * KP;
        f32x4 sc[RG][4];
#pragma unroll
        for (int kh = 0; kh < 2; ++kh) {
            bf16x8 ka[2][NKS];
#pragma unroll
            for (int k1 = 0; k1 < 2; ++k1)
#pragma unroll
                for (int ks = 0; ks < NKS; ++ks) ka[k1][ks] = ld8(Kt + ((2 * kh + k1) * 16 + fr) * KP + ks * 32 + fq * 8);
#pragma unroll
            for (int k1 = 0; k1 < 2; ++k1) {
                const int kb = 2 * kh + k1;
#pragma unroll
                for (int g = 0; g < RG; ++g) sc[g][kb] = (f32x4){0.f, 0.f, 0.f, 0.f};
#pragma unroll
                for (int ks = 0; ks < NKS; ++ks)
#pragma unroll
                    for (int g = 0; g < RG; ++g) sc[g][kb] = mfma16(ka[k1][ks], qf[g][ks], sc[g][kb]);
            }
        }
        if (d.mask && it >= d.ntiles[0]) {
            const int kbase = d.kpos0 + (it - d.ntiles[0]) * 64 + fq * 4;
#pragma unroll
            for (int g = 0; g < RG; ++g)
#pragma unroll
                for (int kb = 0; kb < 4; ++kb)
#pragma unroll
                    for (int r = 0; r < 4; ++r) { const int df = qpos + 16 * g - (kbase + kb * 16 + r); if (df > 128 || df < -128) sc[g][kb][r] = -1e30f; }
        }
        bf16x8 pb[RG][2];
#pragma unroll
        for (int g = 0; g < RG; ++g) {
            float mx = sc[g][0][0];
#pragma unroll
            for (int kb = 0; kb < 4; ++kb)
#pragma unroll
                for (int r = 0; r < 4; ++r) mx = fmaxf(mx, sc[g][kb][r]);
            mx = fmaxf(mx, __shfl_xor(mx, 16)); mx = fmaxf(mx, __shfl_xor(mx, 32));
            const float mnew = fmaxf(mrun[g], mx); const float alpha = __builtin_amdgcn_exp2f(mrun[g] - mnew); mrun[g] = mnew;
            float ps = 0.f;
#pragma unroll
            for (int kb = 0; kb < 4; ++kb)
#pragma unroll
                for (int r = 0; r < 4; ++r) { const float pv = __builtin_amdgcn_exp2f(sc[g][kb][r] - mnew); sc[g][kb][r] = pv; ps += pv; }
            lsum[g] = lsum[g] * alpha + ps;
            pb[g][0] = pack8(sc[g][0], sc[g][1]); pb[g][1] = pack8(sc[g][2], sc[g][3]);
#pragma unroll
            for (int vb = 0; vb < 4; ++vb) oacc[g][vb] = oacc[g][vb] * alpha;
        }
        {
            bf16x8 va[4][2];
#pragma unroll
            for (int vb = 0; vb < 4; ++vb)
#pragma unroll
                for (int k2 = 0; k2 < 2; ++k2) {
                    const bf16_t* vp = VT + ((2 * k2) * 16 + 4 * fq + ((lane & 15) >> 2)) * 72 + 16 * vb + 4 * (lane & 3);
                    const u32x2 t0 = ld_tr4(vp), t1 = ld_tr4(vp + 16 * 72); u32x4 tw; tw.x = t0.x; tw.y = t0.y; tw.z = t1.x; tw.w = t1.y; va[vb][k2] = __builtin_bit_cast(bf16x8, tw);
                }
#pragma unroll
            for (int vb = 0; vb < 4; ++vb)
#pragma unroll
                for (int k2 = 0; k2 < 2; ++k2)
#pragma unroll
                    for (int g = 0; g < RG; ++g) oacc[g][vb] = mfma16(va[vb][k2], pb[g][k2], oacc[g][vb]);
        }
    };
    issue(0, kA0, kA1, vA);
    if (ntot > 1) issue(1, kB0, kB1, vB);
    stage(buf0, kA0, kA1, vA);
    if (ntot > 2) issue(2, kA0, kA1, vA);
    __syncthreads();
#pragma unroll 1
    for (int it = 0; it < ntot; it += 2) {
        if (it + 1 < ntot) stage(buf0 + BUFE, kB0, kB1, vB);
        if (it + 3 < ntot) issue(it + 3, kB0, kB1, vB);
        tile(it);
        __syncthreads();
        if (it + 1 >= ntot) break;
        if (it + 2 < ntot) stage(buf0, kA0, kA1, vA);
        if (it + 4 < ntot) issue(it + 4, kA0, kA1, vA);
        tile(it + 1);
        __syncthreads();
    }
#pragma unroll
    for (int g = 0; g < RG; ++g) {
        float lt = lsum[g] + __shfl_xor(lsum[g], 16); lt += __shfl_xor(lt, 32);
        if (d.has_sink) lt += __builtin_amdgcn_exp2f(d.sink2 - mrun[g]);
        const float inv = 1.0f / lt;
#pragma unroll
        for (int vb = 0; vb < 4; ++vb) {
            u32x2 w; w.x = cvt_pk_bf16(oacc[g][vb][0] * inv, oacc[g][vb][1] * inv); w.y = cvt_pk_bf16(oacc[g][vb][2] * inv, oacc[g][vb][3] * inv);
            *(u32x2*)(d.o + (size_t)(32 * wave + 16 * g + fr) * d.opitch + vb * 16 + fq * 4) = w;
        }
    }
    __syncthreads();
}

__device__ __forceinline__ void phase_mix(const Params& P, int l, unsigned char* smem) {
    unsigned char* ws = P.ws;
    unsigned* ctr = (unsigned*)(ws + WS_CTL) + 64 * (1 + l);
    volatile unsigned* slot = (volatile unsigned*)(smem + LDS_BYTES - 64);
    bf16_t* PROJ = (bf16_t*)(ws + WS_BIG);
    const bf16_t* MLAQ = (const bf16_t*)(ws + WS_MLAQ); const bf16_t* MLAKN = (const bf16_t*)(ws + WS_MLAKN);
    const bf16_t* MLAV = (const bf16_t*)(ws + WS_MLAV); const bf16_t* MLAKR = (const bf16_t*)(ws + WS_MLAKR);
    const bf16_t* SWACK = (const bf16_t*)(ws + WS_SWACK); const bf16_t* SWACV = (const bf16_t*)(ws + WS_SWACV);
    constexpr int N_DNS = 64, N_MLAS = 512, N_SWAS = 512, N_DNP = 256, N_MLAP = 128, N_SWAP = 128;
    constexpr int NTOT = N_DNS + N_MLAS + N_SWAS + N_DNP + N_MLAP + N_SWAP;
    for (;;) {
        if (threadIdx.x == 0) *slot = atomicAdd(ctr, 1u);
        __syncthreads();
        int it = (int)*slot;
        __syncthreads();
        if (it >= NTOT) break;
        if (it < N_DNS) { dn_chain(P, l, true, it >> 3, (it >> 1) & 3, it & 1, smem); continue; } it -= N_DNS;
        if (it < N_MLAS) {
            const int b = it >> 6, h = (it >> 4) & 3, qb = it & 15; const size_t qrow = (size_t)MP + b * 4096 + qb * 256; const size_t kv0 = 8192 + (size_t)b * 4352;
            AttnDesc d; d.q = MLAQ + qrow * 384 + h * 96; d.qpitch = 384; d.o = PROJ + qrow * NP + C_MCQ + h * 64; d.opitch = NP;
            d.k[0] = d.k[1] = MLAKN + kv0 * 256 + h * 64; d.kr[0] = d.kr[1] = MLAKR + kv0 * 32; d.v[0] = d.v[1] = MLAV + kv0 * 256 + h * 64;
            d.kpitch[0] = d.kpitch[1] = 256; d.vpitch[0] = d.vpitch[1] = 256; d.ntiles[0] = 68; d.ntiles[1] = 0; d.mask = 0; d.qpos0 = 0; d.kpos0 = 0; d.sink2 = 0.f; d.has_sink = 0;
            attn_unit<96>(d, smem); continue;
        } it -= N_MLAS;
        if (it < N_SWAS) {
            const int b = it >> 6, hd = (it >> 4) & 3, qb = it & 15, kvh = hd >> 1; const size_t srow = (size_t)MP + b * 4096; const size_t qrow = srow + qb * 256;
            const int klo = qb > 0 ? qb * 256 - 128 : 0; const int khi = qb < 15 ? qb * 256 + 384 : 4096;
            AttnDesc d; d.q = PROJ + qrow * NP + C_SQ + hd * 64; d.qpitch = NP; d.o = PROJ + qrow * NP + C_SQ + hd * 64; d.opitch = NP;
            d.k[0] = SWACK + (size_t)b * 256 * 128 + kvh * 64; d.v[0] = SWACV + (size_t)b * 256 * 128 + kvh * 64; d.kpitch[0] = 128; d.vpitch[0] = 128; d.ntiles[0] = 4;
            d.k[1] = PROJ + (srow + klo) * NP + C_SK + kvh * 64; d.v[1] = PROJ + (srow + klo) * NP + C_SV + kvh * 64; d.kpitch[1] = NP; d.vpitch[1] = NP; d.ntiles[1] = (khi - klo) >> 6;
            d.kr[0] = d.kr[1] = nullptr; d.mask = 1; d.qpos0 = qb * 256; d.kpos0 = klo; d.sink2 = P.in[22][l * 4 + hd] * LOG2E; d.has_sink = 1;
            attn_unit<64>(d, smem); continue;
        } it -= N_SWAS;
        if (it < N_DNP) { dn_chain(P, l, false, it >> 3, (it >> 1) & 3, it & 1, smem); continue; } it -= N_DNP;
        if (it < N_MLAP) {
            const int b = it >> 2, h = it & 3; const size_t qrow = (size_t)b * 256; const size_t kv0 = (size_t)b * 256;
            AttnDesc d; d.q = MLAQ + qrow * 384 + h * 96; d.qpitch = 384; d.o = PROJ + qrow * NP + C_MCQ + h * 64; d.opitch = NP;
            d.k[0] = d.k[1] = MLAKN + kv0 * 256 + h * 64; d.kr[0] = d.kr[1] = MLAKR + kv0 * 32; d.v[0] = d.v[1] = MLAV + kv0 * 256 + h * 64;
            d.kpitch[0] = d.kpitch[1] = 256; d.vpitch[0] = d.vpitch[1] = 256; d.ntiles[0] = 4; d.ntiles[1] = 0; d.mask = 0; d.qpos0 = 0; d.kpos0 = 0; d.sink2 = 0.f; d.has_sink = 0;
            attn_unit<96>(d, smem); continue;
        } it -= N_MLAP;
        {
            const int b = it >> 2, hd = it & 3, kvh = hd >> 1; const size_t srow = (size_t)b * 256; const size_t qrow = srow;
            AttnDesc d; d.q = PROJ + qrow * NP + C_SQ + hd * 64; d.qpitch = NP; d.o = PROJ + qrow * NP + C_SQ + hd * 64; d.opitch = NP;
            d.k[0] = d.k[1] = PROJ + srow * NP + C_SK + kvh * 64; d.v[0] = d.v[1] = PROJ + srow * NP + C_SV + kvh * 64; d.kpitch[0] = d.kpitch[1] = NP; d.vpitch[0] = d.vpitch[1] = NP;
            d.ntiles[0] = 4; d.ntiles[1] = 0; d.kr[0] = d.kr[1] = nullptr; d.mask = 0; d.qpos0 = 0; d.kpos0 = 0; d.sink2 = P.in[22][l * 4 + hd] * LOG2E; d.has_sink = 1;
            attn_unit<64>(d, smem);
        }
    }
}

__device__ __forceinline__ void phase_dnfin(const Params& P, int l) {
    const int tid = opaque(threadIdx.x); const int lane = tid & 63, wave = tid >> 6;
    const int gw = blockIdx.x * 8 + wave, NGW = gridDim.x * 8;
    bf16_t* PROJ = (bf16_t*)(P.ws + WS_BIG);
    const float* g = P.in[17] + l * 128 + (lane & 15) * 8;
    const f32x4 g0 = *(const f32x4*)g, g1 = *(const f32x4*)(g + 4);
    const int rows_per = (M + NGW - 1) / NGW; const int r_begin = gw * rows_per; const int r_end = (r_begin + rows_per) < M ? (r_begin + rows_per) : M;
    if (r_begin >= M) return;
    u32x4 of, ob, z;
    { const bf16_t* pr = PROJ + (size_t)r_begin * NP; of = *(const u32x4*)(pr + C_DV + lane * 8); ob = *(const u32x4*)(pr + C_DK + lane * 8); z = *(const u32x4*)(pr + C_DZ + lane * 8); }
#pragma unroll 1
    for (int m = r_begin; m < r_end; ++m) {
        u32x4 nof, nob, nz;
        if (m + 1 < r_end) { const bf16_t* pr = PROJ + (size_t)(m + 1) * NP; nof = *(const u32x4*)(pr + C_DV + lane * 8); nob = *(const u32x4*)(pr + C_DK + lane * 8); nz = *(const u32x4*)(pr + C_DZ + lane * 8); }
        float o[8]; float ss = 0.f;
#pragma unroll
        for (int e = 0; e < 4; ++e) { o[2 * e] = bflo(of[e]) + bflo(ob[e]); o[2 * e + 1] = bfhi(of[e]) + bfhi(ob[e]); ss += o[2 * e] * o[2 * e] + o[2 * e + 1] * o[2 * e + 1]; }
        ss += __shfl_xor(ss, 1); ss += __shfl_xor(ss, 2); ss += __shfl_xor(ss, 4); ss += __shfl_xor(ss, 8);
        const float rs = 1.0f / sqrtf(ss * (1.f / 128.f) + EPS);
        float y[8];
#pragma unroll
        for (int e = 0; e < 4; ++e) {
            y[2 * e] = o[2 * e] * rs * (e < 2 ? g0[2 * e] : g1[2 * e - 4]) * silu(bflo(z[e]));
            y[2 * e + 1] = o[2 * e + 1] * rs * (e < 2 ? g0[2 * e + 1] : g1[2 * e - 3]) * silu(bfhi(z[e]));
        }
        u32x4 w; w.x = cvt_pk_bf16(y[0], y[1]); w.y = cvt_pk_bf16(y[2], y[3]); w.z = cvt_pk_bf16(y[4], y[5]); w.w = cvt_pk_bf16(y[6], y[7]);
        *(u32x4*)(PROJ + (size_t)m * NP + C_DQ + lane * 8) = w;
        of = nof; ob = nob; z = nz;
    }
}

#define XB_TMO      128
#define XB_XCNT(j)  (256  + 64 * (j))
#define XB_XSUB(j)  (1280 + 64 * (j))
#define XB_XGEN(j)  (2304 + 64 * (j))
#define XB_TOP      3328
#define XB_TOPGEN   3392
#define XCD_BAR_WORDS 3456
#define XB_SPIN_CAP (1u << 22)
__device__ __forceinline__ unsigned xb_ld(unsigned* p)              { return __hip_atomic_load(p, __ATOMIC_RELAXED, __HIP_MEMORY_SCOPE_AGENT); }
__device__ __forceinline__ unsigned xb_add(unsigned* p, unsigned v) { return __hip_atomic_fetch_add(p, v, __ATOMIC_RELAXED, __HIP_MEMORY_SCOPE_AGENT); }
__device__ __forceinline__ unsigned xb_xcc_id() { return (unsigned)__builtin_amdgcn_s_getreg((3 << 11) | 20) & 0xFu; }
#define XB_SPIN(cond, bar) do { unsigned _sp = 0; while (cond) { __builtin_amdgcn_s_sleep(1); \
    if ((++_sp & 255u) == 0u) { if (xb_ld(&(bar)[XB_TMO])) break; if (_sp > XB_SPIN_CAP) { atomicAdd(&(bar)[XB_TMO], 1u); break; } } } } while (0)
struct XcdBarrier { unsigned* bar; unsigned x; volatile unsigned* st; };
__device__ __forceinline__ XcdBarrier xcd_barrier_post(unsigned* bar, volatile unsigned* st) {
    XcdBarrier b; b.bar = bar; b.x = xb_xcc_id(); b.st = st;
    if (threadIdx.x == 0) (void)xb_add(&bar[XB_XCNT(b.x)], 1u);
    return b;
}
__device__ __forceinline__ void xcd_barrier_complete(unsigned* bar, unsigned x, unsigned& nloc, unsigned& nx) {
    const unsigned G = gridDim.x * gridDim.y * gridDim.z;
    unsigned sum, cnt, mine, sp = 0u;
    for (;;) {
        sum = 0u; cnt = 0u; mine = 0u;
#pragma unroll
        for (unsigned j = 0; j < 16; ++j) { const unsigned c = xb_ld(&bar[XB_XCNT(j)]); sum += c; cnt += (c > 0u) ? 1u : 0u; mine = (j == x) ? c : mine; }
        if (sum == G) break;
        __builtin_amdgcn_s_sleep(1);
        if ((++sp & 255u) == 0u) { if (xb_ld(&bar[XB_TMO])) break; if (sp > XB_SPIN_CAP) { atomicAdd(&bar[XB_TMO], 1u); break; } }
    }
    nloc = mine > 0u ? mine : 1u; nx = cnt > 0u ? cnt : 1u;
}
__device__ __forceinline__ void xcd_barrier(const XcdBarrier& b) {
    asm volatile("s_waitcnt vmcnt(0)" ::: "memory");
    __syncthreads();
    if (threadIdx.x == 0) {
        unsigned* bar = b.bar;
        __builtin_amdgcn_s_waitcnt(0);
        unsigned nloc = b.st[0], nx = b.st[1];
        if (nloc == 0u) { xcd_barrier_complete(bar, b.x, nloc, nx); b.st[0] = nloc; b.st[1] = nx; }
        const unsigned old = xb_add(&bar[XB_XSUB(b.x)], 1u);
        const unsigned gen = old / nloc;
        if (old + 1u == (gen + 1u) * nloc) {
            __builtin_amdgcn_fence(__ATOMIC_RELEASE, "agent");
            asm volatile("s_waitcnt vmcnt(0)" ::: "memory");
            const unsigned og = xb_add(&bar[XB_TOP], 1u);
            const unsigned tg = og / nx;
            if (og + 1u == (tg + 1u) * nx) xb_add(&bar[XB_TOPGEN], 1u);
            else XB_SPIN(xb_ld(&bar[XB_TOPGEN]) == tg, bar);
            __builtin_amdgcn_fence(__ATOMIC_ACQUIRE, "agent");
            xb_add(&bar[XB_XGEN(b.x)], 1u);
            asm volatile("s_waitcnt vmcnt(0)" ::: "memory");
        } else {
            XB_SPIN(xb_ld(&bar[XB_XGEN(b.x)]) == gen, bar);
            __builtin_amdgcn_fence(__ATOMIC_ACQUIRE, "agent");
            asm volatile("s_waitcnt vmcnt(0)" ::: "memory");
        }
    }
    __syncthreads();
}

constexpr int NPH = 1 + 2 * 9 + 1;
__global__ void __launch_bounds__(512, 2) mega(Params P, int ph_lo, int ph_hi) {
    extern __shared__ __attribute__((aligned(16))) unsigned char smem[];
    cg::grid_group grid = cg::this_grid();
    unsigned char* ws = P.ws;
    LAS unsigned char* lds = (LAS unsigned char*)smem;
    volatile unsigned* xst = (volatile unsigned*)(smem + LDS_BYTES - 32);
    if (threadIdx.x == 0) { xst[0] = 0u; xst[1] = 0u; }
    __syncthreads();
    XcdBarrier xbar = xcd_barrier_post((unsigned*)(ws + WS_CTL) + 4096, xst);
    int ph = 0;
#ifndef PHMASK
#define PHMASK 0xffff
#endif
#define RUN(cat, ...) do { if (ph >= ph_lo && ph < ph_hi) { if ((PHMASK >> (cat)) & 1) { __VA_ARGS__; } if (ph + 1 < ph_hi) { if (ph_lo < 0) { asm volatile("s_waitcnt vmcnt(0) lgkmcnt(0)" ::: "memory"); grid.sync(); if (threadIdx.x < 64) { __builtin_amdgcn_fence(__ATOMIC_ACQUIRE, "agent"); asm volatile("s_waitcnt vmcnt(0)" ::: "memory"); } __syncthreads(); } else xcd_barrier(xbar); } } ++ph; } while (0)
    RUN(0, phase0(P, smem));
    for (int l = 0; l < 2; ++l) {
        const float* modv = (const float*)(ws + WS_MODV) + (size_t)l * 9 * 6144;
        RUN(1, phase_norm(P, l, 0));
        RUN(2, { pg8::Gemm g{(const bf16_t*)(ws + WS_H), (const bf16_t*)(ws + WS_WIN) + (size_t)l * 3072 * 1024, M, NP, D, D}; pg8::StaticOrder S; S.init(M, NP, gridDim.x, blockIdx.x);
              pg8::EpiProj E{(bf16_t*)(ws + WS_BIG), (bf16_t*)(ws + WS_HALO), P.out + O_KR, P.out + O_SK, P.out + O_SV, l};
              pg8::gemm_phase<pg8::EpiProj, true, true>(lds, g, S, E); });
        RUN(3, { for (int t = blockIdx.x; t < 640 + 32; t += gridDim.x) { if (t < 640) post_tile(P, l, t, smem); else ctx_tile(P, l, t - 640, smem); } });
        RUN(4, phase_mix(P, l, smem));
        RUN(5, phase_dnfin(P, l));
        RUN(6, { pg8::Gemm g{(const bf16_t*)(ws + WS_BIG), (const bf16_t*)(ws + WS_WOUT) + (size_t)l * 1024 * 1024, M, D, D, NP}; pg8::StaticOrder S; S.init(M, D, gridDim.x, blockIdx.x);
              pg8::EpiResid E{P.out, modv + 2048, l == 0 ? P.in[0] : nullptr, l == 0 ? P.in[1] : nullptr};
              pg8::gemm_phase<pg8::EpiResid, true, true>(lds, g, S, E); });
        RUN(1, phase_norm(P, l, 1));
        RUN(7, { pg8::Gemm g{(const bf16_t*)(ws + WS_H), (const bf16_t*)(ws + WS_WFF1) + (size_t)l * 4096 * 1024, M, FF, D, D}; pg8::StaticOrder S; S.init(M, FF, gridDim.x, blockIdx.x);
              pg8::EpiRelu2 E{(bf16_t*)(ws + WS_BIG)};
              pg8::gemm_phase<pg8::EpiRelu2, true, true>(lds, g, S, E); });
        RUN(8, { pg8::Gemm g{(const bf16_t*)(ws + WS_BIG), (const bf16_t*)(ws + WS_WFF2) + (size_t)l * 1024 * 4096, M, D, FF, FF}; pg8::StaticOrder S; S.init(M, D, gridDim.x, blockIdx.x);
              pg8::EpiResid E{P.out, modv + 5120, nullptr, nullptr};
              pg8::gemm_phase<pg8::EpiResid, true, true>(lds, g, S, E); });
    }
    RUN(9, phase_final(P));
#undef RUN
}

#ifndef PH_END
#define PH_END NPH
#endif
#ifndef MULTI_LAUNCH
#define MULTI_LAUNCH 0
#endif
extern "C" void kernel_launch(void* const* d_in, const int* in_sizes, int n_in, void* d_out, int out_size, void* d_ws, size_t ws_size, hipStream_t stream) {
    static int grid = 0;
    if (grid == 0) {
        if (n_in != 27 || ws_size < WS_END) { fprintf(stderr, "kernel_launch: unexpected n_in %d / ws_size %zu\n", n_in, ws_size); grid = -1; return; }
        int dev = 0, cus = 0, per_cu = 0;
        hipGetDevice(&dev); hipDeviceGetAttribute(&cus, hipDeviceAttributeMultiprocessorCount, dev);
        if (hipFuncSetAttribute((const void*)mega, hipFuncAttributeMaxDynamicSharedMemorySize, LDS_BYTES) != hipSuccess) { fprintf(stderr, "kernel_launch: hipFuncSetAttribute failed\n"); grid = -1; return; }
        hipOccupancyMaxActiveBlocksPerMultiprocessor(&per_cu, (const void*)mega, 512, LDS_BYTES);
        if (per_cu < 1) { fprintf(stderr, "kernel_launch: occupancy query says %d\n", per_cu); per_cu = 1; }
        (void)hipGetLastError();
        grid = cus * per_cu;
    }
    if (grid < 0) return;
    hipMemsetAsync((char*)d_ws + WS_CTL, 0, 32768, stream);
    Params p{};
    for (int i = 0; i < 27; ++i) p.in[i] = (const float*)d_in[i];
    p.out = (float*)d_out; p.ws = (unsigned char*)d_ws;
#if MULTI_LAUNCH
    for (int ph = 0; ph < PH_END; ++ph) hipLaunchKernelGGL(mega, dim3(grid), dim3(512), LDS_BYTES, stream, p, ph, ph + 1);
#else
    int lo = 0, hi = PH_END;
    void* args[] = {&p, &lo, &hi};
    hipError_t e = hipLaunchCooperativeKernel((const void*)mega, dim3(grid), dim3(512), args, LDS_BYTES, stream);
    if (e != hipSuccess) fprintf(stderr, "cooperative launch failed: %s (grid %d)\n", hipGetErrorString(e), grid);
#endif
}
```

```cpp
#include <hip/hip_runtime.h>
#define PHMASK 0xffff
#define MIXMASK 15
#define DBG_NOA 0
#define PROBE_SEL 0
#include <hip/hip_cooperative_groups.h>
#include <cstdio>
#include <cstdint>
namespace cg = cooperative_groups;

#define LAS __attribute__((address_space(3)))
typedef unsigned short bf16_t;
typedef short bf16x8 __attribute__((ext_vector_type(8)));
typedef float f32x4 __attribute__((ext_vector_type(4)));
typedef float f32x2 __attribute__((ext_vector_type(2)));
typedef unsigned u32x4 __attribute__((ext_vector_type(4)));
typedef unsigned u32x2 __attribute__((ext_vector_type(2)));

constexpr int D = 1024, MP = 8192, MS = 32768, M = MP + MS, NP = 3072, FF = 4096;
constexpr int C_DQ = 0, C_MCQ = 512, C_SQ = 768, C_DK = 1024, C_DV = 1536, C_DZ = 2048, C_AB = 2560, C_MCKV = 2576, C_MKR = 2704, C_SK = 2736, C_SV = 2864;
constexpr int KVROWS = 8192 + 8 * 4352;
constexpr float LOG2E = 1.4426950408889634f;
constexpr float EPS = 1e-6f;

constexpr size_t MiB = 1u << 20;
constexpr size_t WS_CTL = 0;
constexpr size_t WS_MODV = 1 * MiB;
constexpr size_t WS_GB = 2 * MiB;
constexpr size_t WS_GC = 5 * MiB;
constexpr size_t WS_SWACK = 7 * MiB;
constexpr size_t WS_SWACV = 7 * MiB + 512 * 1024;
constexpr size_t WS_W = 8 * MiB;
constexpr size_t WS_WIN = WS_W;
constexpr size_t WS_WOUT = WS_WIN + 12 * MiB;
constexpr size_t WS_WFF1 = WS_WOUT + 4 * MiB;
constexpr size_t WS_WFF2 = WS_WFF1 + 16 * MiB;
constexpr size_t WS_WUQ = WS_WFF2 + 16 * MiB;
constexpr size_t WS_WUKV = WS_WUQ + 512 * 1024;
constexpr size_t WS_H = 57 * MiB;
constexpr size_t WS_BIG = 137 * MiB;
constexpr size_t WS_DNV = WS_BIG + 240 * MiB;
constexpr size_t WS_MLAQ = WS_DNV + 40 * MiB;
constexpr size_t WS_MLAKN = 457 * MiB;
constexpr size_t WS_MLAV = 478 * MiB;
constexpr size_t WS_MLAKR = 499 * MiB;
constexpr size_t WS_ROPEM = 502 * MiB;
constexpr size_t WS_ROPES = 502 * MiB + 512 * 1024;
constexpr size_t WS_HALO = 504 * MiB;
constexpr size_t WS_END = 508 * MiB;

constexpr size_t O_STATE = (size_t)M * D;
constexpr size_t O_CKV = O_STATE + 8388608;
constexpr size_t O_KR = O_CKV + 2097152;
constexpr size_t O_SK = O_KR + 524288;
constexpr size_t O_SV = O_SK + 2097152;

constexpr int LDS_BYTES = 147456;

struct Params { const float* in[27]; float* out; unsigned char* ws; };

typedef float f32x2_t __attribute__((ext_vector_type(2))); typedef __bf16 bf16x2_t __attribute__((ext_vector_type(2)));
__device__ __forceinline__ unsigned cvt_pk_bf16(float lo, float hi) { f32x2_t v = {lo, hi}; bf16x2_t b = __builtin_convertvector(v, bf16x2_t); return __builtin_bit_cast(unsigned, b); }
__device__ __forceinline__ unsigned short f2bf(float f) { return (unsigned short)(cvt_pk_bf16(f, 0.f) & 0xffffu); }
__device__ __forceinline__ float bf2f(unsigned short h) { return __uint_as_float((unsigned)h << 16); }
__device__ __forceinline__ float bflo(unsigned u) { return __uint_as_float(u << 16); }
__device__ __forceinline__ float bfhi(unsigned u) { return __uint_as_float(u & 0xffff0000u); }
__device__ __forceinline__ bf16x8 pack8(f32x4 a, f32x4 b) {
    u32x4 w; w.x = cvt_pk_bf16(a[0], a[1]); w.y = cvt_pk_bf16(a[2], a[3]); w.z = cvt_pk_bf16(b[0], b[1]); w.w = cvt_pk_bf16(b[2], b[3]);
    return __builtin_bit_cast(bf16x8, w);
}
__device__ __forceinline__ bf16x8 ld2x4(const bf16_t* p0, const bf16_t* p1) {
    u32x2 a = *(const u32x2*)p0, b = *(const u32x2*)p1; u32x4 w; w.x = a.x; w.y = a.y; w.z = b.x; w.w = b.y; return __builtin_bit_cast(bf16x8, w);
}
typedef short v4i16_t __attribute__((ext_vector_type(4)));
__device__ __forceinline__ u32x2 ld_tr4(const bf16_t* p) { return __builtin_bit_cast(u32x2, __builtin_amdgcn_ds_read_tr16_b64_v4i16((LAS v4i16_t*)p)); }
__device__ __forceinline__ bf16x8 ld8(const bf16_t* p) { return __builtin_bit_cast(bf16x8, *(const u32x4*)p); }
__device__ __forceinline__ f32x4 mfma16(bf16x8 a, bf16x8 b, f32x4 c) { return __builtin_amdgcn_mfma_f32_16x16x32_bf16(a, b, c, 0, 0, 0); }
__device__ __forceinline__ float wave_sum(float v) {
#pragma unroll
    for (int o = 1; o < 64; o <<= 1) v += __shfl_xor(v, o);
    return v;
}
__device__ __forceinline__ float fexp(float x) { return __builtin_amdgcn_exp2f(x * LOG2E); }
__device__ __forceinline__ float silu(float x) { return x / (1.f + fexp(-x)); }
__device__ __forceinline__ int win_dst(int n) {
    if (n < 512) return C_DQ + n;
    if (n < 1024) return C_DK + (n - 512);
    if (n < 1536) return C_DV + (n - 1024);
    if (n < 2048) return C_DZ + (n - 1536);
    if (n < 2064) return C_AB + (n - 2048);
    if (n < 2320) return C_MCQ + (n - 2064);
    if (n < 2448) return C_MCKV + (n - 2320);
    if (n < 2480) return C_MKR + (n - 2448);
    if (n < 2736) return C_SQ + (n - 2480);
    return n;
}
#define LDS_WAIT() asm volatile("s_waitcnt lgkmcnt(0)" ::: "memory")
__device__ __forceinline__ void probe_max(unsigned char* ws, int slot, float v) { if (v == v) atomicMax((int*)(ws + 2048) + slot, __float_as_int(fabsf(v))); else atomicMax((int*)(ws + 2048) + slot, 0x7f000000); }
__device__ __forceinline__ int opaque(int x) { asm volatile("" : "+v"(x)); return x; }
#define LOCAL_LANES const int tid = opaque(tid0), lane = tid & 63, fr = lane & 15, fq = lane >> 4; (void)fr; (void)fq; (void)lane

namespace pg8 {
constexpr int BM = 256, BK = 64, HALF = 128, HTB = HALF * BK * 2, STAGE_BYTES = 8 * HTB, NXCD = 8, WGM = 8;
__host__ __device__ __forceinline__ int lds_byte(int r, int c) { const int st = (r >> 4) * 2 + (c >> 5), rr = r & 15, cc = c & 31, ob = rr * 64 + cc * 2; return st * 1024 + (ob ^ (((ob >> 9) & 1) << 5)); }
__host__ __device__ __forceinline__ void stage_rc(int b, int& R, int& C) { const int st = b / 1024, sb = b % 1024, swz = sb ^ (((sb >> 9) & 1) << 5); R = (st >> 1) * 16 + swz / 64; C = (st & 1) * 32 + (swz % 64) / 2; }
__host__ __device__ __forceinline__ int perm32(int rho) { const int n = rho >> 4, i = rho & 15; return 8 * (i >> 2) + 4 * n + (i & 3); }
struct Unit { int pm, pn; };
struct Gemm { const bf16_t* A; const bf16_t* Bt; int M, N, K, lda; };
struct StaticOrder {
    int nM, nN, nwg, G, c;
    __device__ void init(int M_, int N_, int G_, int c_) { nM = M_ / BM; nN = N_ / BM; nwg = nM * nN; G = G_; c = c_; }
    __device__ bool next(int i, Unit& u) const {
        const long L = (long)i * G + c; if (L >= nwg) return false;
        int wgid = (int)L; { const int q = nwg / NXCD, r = nwg % NXCD, xcd = wgid % NXCD, off = wgid / NXCD; wgid = (xcd < r ? xcd * (q + 1) : r * (q + 1) + (xcd - r) * q) + off; }
        const int nig = WGM * nN, gid = wgid / nig, fm = gid * WGM, gsz = (nM - fm) < WGM ? (nM - fm) : WGM;
        u.pm = fm + ((wgid % nig) % gsz); u.pn = (wgid % nig) / gsz; return true;
    }
};

template <class Epi, bool ALIGN_EPI, bool SP2>
__device__ __forceinline__ void gemm_phase(LAS unsigned char* lds, const Gemm g, const StaticOrder& S, const Epi& E) {
    const int tid = opaque(threadIdx.x), wid = __builtin_amdgcn_readfirstlane(tid >> 6), lane = tid & 63, wr = wid >> 2, wc = wid & 3, fr = lane & 15, fq = lane >> 4;
    const int K = g.K, nt = K / BK, lda = g.lda;
    unsigned voffA[2], voffB[2];
#pragma unroll
    for (int i = 0; i < 2; ++i) { int R, C; stage_rc(tid * 16 + i * 8192, R, C); const int Rb = Epi::PERM ? ((R & ~31) + perm32(R & 31)) : R;
        voffA[i] = (unsigned)(R * lda + C) * 2u; voffB[i] = (unsigned)(Rb * K + C) * 2u; }
    const size_t kstep = (size_t)(BK * 2);
    const size_t hstepA = (size_t)HALF * lda * 2, hstepB = (size_t)HALF * K * 2;
    const size_t tstepA = 2 * hstepA, tstepB = 2 * hstepB;
    const unsigned ldsw = (unsigned)wid * 1024u;
    const int aoff = lds_byte(wr * 64 + fr, fq * 8), boff = lds_byte(wc * 32 + fr, fq * 8);
#define PG8_SA(b, h) (((b) * 2 + (h)) * HTB)
#define PG8_SB(b, h) ((4 + (b) * 2 + (h)) * HTB)
#define PG8_STAGE(bufoff, gbase, voff) do { _Pragma("unroll") for (int _i = 0; _i < 2; ++_i) \
        __builtin_amdgcn_global_load_lds((const unsigned*)((const char*)(gbase) + (voff)[_i]), (LAS unsigned*)(lds + (bufoff) + ldsw + _i * 8192), 16, 0, 0); } while (0)
#define PG8_LDA(dst, b, h) do { _Pragma("unroll") for (int m = 0; m < 4; ++m) _Pragma("unroll") for (int k = 0; k < 2; ++k) dst[m][k] = *(const LAS bf16x8*)(lds + PG8_SA(b, h) + aoff + m * 2048 + k * 1024); } while (0)
#define PG8_LDB(dst, b, h) do { _Pragma("unroll") for (int n = 0; n < 2; ++n) _Pragma("unroll") for (int k = 0; k < 2; ++k) dst[n][k] = *(const LAS bf16x8*)(lds + PG8_SB(b, h) + boff + n * 2048 + k * 1024); } while (0)
#define PG8_MMA(ai, bj, At, Bt) do { __builtin_amdgcn_s_setprio(1); _Pragma("unroll") for (int m = 0; m < 4; ++m) _Pragma("unroll") for (int n = 0; n < 2; ++n) _Pragma("unroll") for (int k = 0; k < 2; ++k) \
        acc[ai][bj][m][n] = __builtin_amdgcn_mfma_f32_16x16x32_bf16(Bt[n][k], At[m][k], acc[ai][bj][m][n], 0, 0, 0); __builtin_amdgcn_s_setprio(0); } while (0)
#define PG8_WAIT_V(n) asm volatile("s_waitcnt vmcnt(" #n ")" ::: "memory")
#define PG8_WAIT_L(n) asm volatile("s_waitcnt lgkmcnt(" #n ")" ::: "memory")
#define PG8_BAR __builtin_amdgcn_s_barrier()
#define PG8_SCHED __builtin_amdgcn_sched_barrier(0)
    Unit cur, nxt; int ui = 0;
    if (!S.next(0, cur)) return;
    f32x4 acc[2][2][4][2];
#pragma unroll
    for (int a = 0; a < 2; ++a)
#pragma unroll
        for (int b = 0; b < 2; ++b)
#pragma unroll
            for (int m = 0; m < 4; ++m)
#pragma unroll
                for (int n = 0; n < 2; ++n) acc[a][b][m][n] = (f32x4){0.f, 0.f, 0.f, 0.f};
    bf16x8 At[4][2], B0[2][2], B1[2][2];
    const char* cA = (const char*)g.A + (size_t)cur.pm * tstepA; const char* cB = (const char*)g.Bt + (size_t)cur.pn * tstepB;
    if constexpr (SP2) {
        PG8_STAGE(PG8_SB(0, 0), cB, voffB); PG8_STAGE(PG8_SB(0, 1), cB + hstepB, voffB); PG8_STAGE(PG8_SA(0, 0), cA, voffA); PG8_STAGE(PG8_SA(0, 1), cA + hstepA, voffA);
        if (wr == 1) PG8_BAR;
        PG8_WAIT_V(2); PG8_BAR;
        PG8_STAGE(PG8_SB(1, 0), cB + kstep, voffB); PG8_STAGE(PG8_SA(1, 0), cA + kstep, voffA); PG8_STAGE(PG8_SB(1, 1), cB + hstepB + kstep, voffB);
        PG8_WAIT_V(6); PG8_BAR;
    } else {
        PG8_STAGE(PG8_SB(0, 0), cB, voffB); PG8_STAGE(PG8_SA(0, 0), cA, voffA); PG8_STAGE(PG8_SB(0, 1), cB + hstepB, voffB); PG8_STAGE(PG8_SA(0, 1), cA + hstepA, voffA);
        if (wr == 1) PG8_BAR;
        PG8_WAIT_V(4); PG8_BAR;
        PG8_STAGE(PG8_SB(1, 0), cB + kstep, voffB); PG8_STAGE(PG8_SA(1, 0), cA + kstep, voffA); PG8_STAGE(PG8_SB(1, 1), cB + hstepB + kstep, voffB);
        PG8_WAIT_V(6); PG8_BAR;
    }
    for (;;) {
        const bool has_next = S.next(ui + 1, nxt);
        const char* nA = has_next ? (const char*)g.A + (size_t)nxt.pm * tstepA : cA; const char* nB = has_next ? (const char*)g.Bt + (size_t)nxt.pn * tstepB : cB;
        for (int t = 0; t < nt; t += 2) {
            const bool last = (t == nt - 2);
            const char* a1 = cA + (size_t)(t + 1) * kstep;
            const char* a2 = last ? nA : cA + (size_t)(t + 2) * kstep; const char* b2 = last ? nB : cB + (size_t)(t + 2) * kstep;
            const char* a3 = a2 + kstep; const char* b3 = b2 + kstep;
            if constexpr (SP2) {
            PG8_LDB(B0, 0, 0); PG8_LDB(B1, 0, 1); PG8_SCHED; PG8_LDA(At, 0, 0); PG8_STAGE(PG8_SA(1, 1), a1 + hstepA, voffA);
            PG8_WAIT_V(8); PG8_WAIT_L(0); PG8_BAR; PG8_MMA(0, 0, At, B0); PG8_MMA(0, 1, At, B1); PG8_BAR; PG8_SCHED;
            PG8_LDA(At, 0, 1); PG8_STAGE(PG8_SB(0, 0), b2, voffB); PG8_STAGE(PG8_SB(0, 1), b2 + hstepB, voffB); PG8_STAGE(PG8_SA(0, 0), a2, voffA);
            PG8_WAIT_V(8); PG8_WAIT_L(0); PG8_BAR; PG8_MMA(1, 0, At, B0); PG8_MMA(1, 1, At, B1); PG8_BAR; PG8_SCHED;
            PG8_LDB(B0, 1, 0); PG8_LDB(B1, 1, 1); PG8_SCHED; PG8_LDA(At, 1, 0); PG8_STAGE(PG8_SA(0, 1), a2 + hstepA, voffA);
            PG8_WAIT_V(8); PG8_WAIT_L(0); PG8_BAR; PG8_MMA(0, 0, At, B0); PG8_MMA(0, 1, At, B1); PG8_BAR; PG8_SCHED;
            PG8_LDA(At, 1, 1); PG8_STAGE(PG8_SB(1, 0), b3, voffB); PG8_STAGE(PG8_SB(1, 1), b3 + hstepB, voffB); PG8_STAGE(PG8_SA(1, 0), a3, voffA);
            PG8_WAIT_V(8); PG8_WAIT_L(0); PG8_BAR; PG8_MMA(1, 0, At, B0); PG8_MMA(1, 1, At, B1); PG8_BAR; PG8_SCHED;
            } else {
            PG8_LDB(B0, 0, 0); PG8_SCHED; PG8_LDA(At, 0, 0); PG8_STAGE(PG8_SA(1, 1), a1 + hstepA, voffA);
            PG8_WAIT_L(8); PG8_BAR; PG8_WAIT_L(0); PG8_MMA(0, 0, At, B0); PG8_BAR; PG8_SCHED;
            PG8_LDB(B1, 0, 1); PG8_STAGE(PG8_SB(0, 0), b2, voffB);
            PG8_BAR; PG8_WAIT_L(0); PG8_MMA(0, 1, At, B1); PG8_BAR;
            PG8_LDA(At, 0, 1); PG8_STAGE(PG8_SA(0, 0), a2, voffA);
            PG8_BAR; PG8_WAIT_L(0); PG8_MMA(1, 0, At, B0); PG8_BAR; PG8_SCHED;
            PG8_STAGE(PG8_SB(0, 1), b2 + hstepB, voffB);
            PG8_WAIT_V(6); PG8_BAR; PG8_MMA(1, 1, At, B1); PG8_BAR;
            PG8_LDB(B0, 1, 0); PG8_SCHED; PG8_LDA(At, 1, 0); PG8_STAGE(PG8_SA(0, 1), a2 + hstepA, voffA);
            PG8_WAIT_L(8); PG8_BAR; PG8_WAIT_L(0); PG8_MMA(0, 0, At, B0); PG8_BAR; PG8_SCHED;
            PG8_LDB(B1, 1, 1); PG8_STAGE(PG8_SB(1, 0), b3, voffB);
            PG8_BAR; PG8_WAIT_L(0); PG8_MMA(0, 1, At, B1); PG8_BAR;
            PG8_LDA(At, 1, 1); PG8_STAGE(PG8_SA(1, 0), a3, voffA);
            PG8_BAR; PG8_WAIT_L(0); PG8_MMA(1, 0, At, B0); PG8_BAR; PG8_SCHED;
            PG8_STAGE(PG8_SB(1, 1), b3 + hstepB, voffB);
            PG8_WAIT_V(6); PG8_BAR; PG8_MMA(1, 1, At, B1); PG8_BAR;
            }
        }
        if constexpr (ALIGN_EPI) { if (wr == 0) PG8_BAR; }
        E(acc, cur, wr, wc, fr, fq);
        if (!has_next) break;
#pragma unroll
        for (int a = 0; a < 2; ++a)
#pragma unroll
            for (int b = 0; b < 2; ++b)
#pragma unroll
                for (int m = 0; m < 4; ++m)
#pragma unroll
                    for (int n = 0; n < 2; ++n) acc[a][b][m][n] = (f32x4){0.f, 0.f, 0.f, 0.f};
        cur = nxt; cA = nA; cB = nB; ++ui;
        if constexpr (ALIGN_EPI) { if (wr == 1) PG8_BAR; }
    }
    PG8_WAIT_V(0);
    if constexpr (!ALIGN_EPI) { if (wr == 0) PG8_BAR; }
    PG8_BAR;
#undef PG8_SA
#undef PG8_SB
#undef PG8_STAGE
#undef PG8_LDA
#undef PG8_LDB
#undef PG8_MMA
#undef PG8_WAIT_V
#undef PG8_WAIT_L
#undef PG8_BAR
#undef PG8_SCHED
}

struct EpiProj {
    static constexpr bool PERM = true;
    bf16_t* O; bf16_t* halo; float* out_kr; float* out_sk; float* out_sv; int l;
    __device__ __forceinline__ void operator()(const f32x4 (&acc)[2][2][4][2], const Unit& u, int wr, int wc, int fr, int fq) const {
        const int row0 = u.pm * BM + wr * 64 + fr; const int col0 = u.pn * BM + wc * 32 + 8 * fq;
#pragma unroll
        for (int ai = 0; ai < 2; ++ai)
#pragma unroll
            for (int m = 0; m < 4; ++m) {
                const int row = row0 + ai * HALF + m * 16;
#pragma unroll
                for (int bj = 0; bj < 2; ++bj) {
                    const int col = col0 + bj * HALF;
                    const f32x4 v0 = acc[ai][bj][m][0], v1 = acc[ai][bj][m][1];
                    u32x4 w; w.x = cvt_pk_bf16(v0[0], v0[1]); w.y = cvt_pk_bf16(v0[2], v0[3]); w.z = cvt_pk_bf16(v1[0], v1[1]); w.w = cvt_pk_bf16(v1[2], v1[3]);
                    *(u32x4*)(O + (size_t)row * NP + col) = w;
                    if (u.pn >= 10 && row < MP && col >= C_MKR && col < 2992) {
                        const int b = row >> 8, t = row & 255; const size_t tok = (size_t)(b * 2 + l) * 256 + t;
                        float* dst = (col < C_SK) ? out_kr + tok * 32 + (col - C_MKR) : (col < C_SV) ? out_sk + tok * 128 + (col - C_SK) : out_sv + tok * 128 + (col - C_SV);
                        *(f32x4*)dst = v0; *(f32x4*)(dst + 4) = v1;
                    }
                    const int r63 = row & 63;
                    if ((r63 == 0 || r63 == 63) && (col < 512 || (col >= 1024 && col < 2048))) {
                        const int hc = col < 512 ? col : col - 512;
                        *(u32x4*)(halo + (size_t)((row >> 6) * 2 + (r63 == 63)) * 1536 + hc) = w;
                    }
                }
            }
    }
};
struct EpiRelu2 {
    static constexpr bool PERM = true;
    bf16_t* O;
    __device__ __forceinline__ void operator()(const f32x4 (&acc)[2][2][4][2], const Unit& u, int wr, int wc, int fr, int fq) const {
        const int row0 = u.pm * BM + wr * 64 + fr; const int col0 = u.pn * BM + wc * 32 + 8 * fq;
#pragma unroll
        for (int ai = 0; ai < 2; ++ai)
#pragma unroll
            for (int m = 0; m < 4; ++m) {
                bf16_t* rowp = O + (size_t)(row0 + ai * HALF + m * 16) * FF + col0;
#pragma unroll
                for (int bj = 0; bj < 2; ++bj) {
                    f32x4 v0 = acc[ai][bj][m][0], v1 = acc[ai][bj][m][1];
#pragma unroll
                    for (int e = 0; e < 4; ++e) { float a = fmaxf(v0[e], 0.f); v0[e] = a * a; float b = fmaxf(v1[e], 0.f); v1[e] = b * b; }
                    u32x4 w; w.x = cvt_pk_bf16(v0[0], v0[1]); w.y = cvt_pk_bf16(v0[2], v0[3]); w.z = cvt_pk_bf16(v1[0], v1[1]); w.w = cvt_pk_bf16(v1[2], v1[3]);
                    *(u32x4*)(rowp + bj * HALF) = w;
                }
            }
    }
};
struct EpiResid {
    static constexpr bool PERM = false;
    float* X; const float* gate; const float* basep; const float* bases;
    __device__ __forceinline__ void operator()(const f32x4 (&acc)[2][2][4][2], const Unit& u, int wr, int wc, int fr, int fq) const {
        const int rowt = u.pm * BM; const int bi = rowt < MP ? 0 : 1 + ((rowt - MP) >> 12);
        const float* gp = gate + (size_t)bi * 6144;
        const int col0 = u.pn * BM + wc * 32 + 4 * fq;
        f32x4 gv[2][2];
#pragma unroll
        for (int bj = 0; bj < 2; ++bj)
#pragma unroll
            for (int n = 0; n < 2; ++n) gv[bj][n] = *(const f32x4*)(gp + col0 + bj * HALF + n * 16);
#pragma unroll
        for (int ai = 0; ai < 2; ++ai)
#pragma unroll
            for (int m = 0; m < 4; ++m) {
                const size_t roff = (size_t)(rowt + ai * HALF + wr * 64 + m * 16 + fr) * D + col0;
                float* rowp = X + roff; const float* srcp = basep ? (rowt < MP ? basep + roff : bases + (roff - (size_t)MP * D)) : rowp;
#pragma unroll
                for (int bj = 0; bj < 2; ++bj)
#pragma unroll
                    for (int n = 0; n < 2; ++n) { f32x4* xp = (f32x4*)(rowp + bj * HALF + n * 16); f32x4 x = *(const f32x4*)(srcp + bj * HALF + n * 16); x = x + gv[bj][n] * acc[ai][bj][m][n]; *xp = x; }
            }
    }
};
}

template <bool WIN>
__device__ __forceinline__ void transpose_item(const float* W, int K, int Nsrc, bf16_t* WT, float* scr, int kb, int nb, int lane) {
    const int k0 = 64 * kb, n0 = 32 * nb;
    float tmp[32];
#pragma unroll
    for (int i = 0; i < 32; ++i) { const int kk = 2 * i + (lane >> 5); const int n = n0 + (lane & 31); tmp[i] = (n < Nsrc) ? W[(size_t)(k0 + kk) * Nsrc + n] : 0.f; }
#pragma unroll
    for (int i = 0; i < 32; ++i) { const int kk = 2 * i + (lane >> 5); scr[kk * 33 + (lane & 31)] = tmp[i]; }
    LDS_WAIT();
    const int c = lane & 7;
#pragma unroll
    for (int j = 0; j < 4; ++j) { const int n = (lane >> 3) + 8 * j; const float* s = scr + (8 * c) * 33 + n;
        u32x4 o; o.x = cvt_pk_bf16(s[0 * 33], s[1 * 33]); o.y = cvt_pk_bf16(s[2 * 33], s[3 * 33]); o.z = cvt_pk_bf16(s[4 * 33], s[5 * 33]); o.w = cvt_pk_bf16(s[6 * 33], s[7 * 33]);
        const int dn = WIN ? win_dst(n0 + n) : (n0 + n);
        *(u32x4*)(WT + (size_t)dn * K + k0 + 8 * c) = o; }
    LDS_WAIT();
}

__device__ __forceinline__ void phase0(const Params& P, unsigned char* smem) {
    const int tid = opaque(threadIdx.x), lane = tid & 63, wave = tid >> 6;
    unsigned char* ws = P.ws;
    if (blockIdx.x < 192) {
        float* sv = (float*)smem;
        float* red = sv + 9 * 1024;
        const int l = blockIdx.x / 96, cb = blockIdx.x % 96;
        for (int i = tid; i < 9 * 1024; i += 512) { const int v = i >> 10, k = i & 1023; const float x = (v == 0) ? P.in[8][k] : P.in[7][(v - 1) * 1024 + k]; sv[i] = silu(x); }
        __syncthreads();
        const float* aw = P.in[9] + (size_t)l * 1024 * 6144 + cb * 64 + lane;
        float acc[9];
#pragma unroll
        for (int i = 0; i < 9; ++i) acc[i] = 0.f;
        const int kb = wave * 128;
#pragma unroll 16
        for (int k = 0; k < 128; ++k) { const float a = aw[(size_t)(kb + k) * 6144];
#pragma unroll
            for (int i = 0; i < 9; ++i) acc[i] += sv[i * 1024 + kb + k] * a; }
#pragma unroll
        for (int i = 0; i < 9; ++i) red[(wave * 9 + i) * 64 + lane] = acc[i];
        __syncthreads();
        for (int o = tid; o < 9 * 64; o += 512) { const int i = o >> 6, c = o & 63; float s = P.in[10][l * 6144 + cb * 64 + c];
#pragma unroll
            for (int w = 0; w < 8; ++w) s += red[(w * 9 + i) * 64 + c];
            ((float*)(ws + WS_MODV))[(size_t)(l * 9 + i) * 6144 + cb * 64 + c] = s; }
        __syncthreads();
    }
    {
        const int gt = blockIdx.x * 512 + tid, NT = gridDim.x * 512;
        f32x2* rm = (f32x2*)(ws + WS_ROPEM); f32x2* rs = (f32x2*)(ws + WS_ROPES);
        for (int i = gt; i < 4096 * 48; i += NT) {
            const int t = i / 48, j = i % 48; float ang;
            if (j < 16) { const int jj = j & 7; const float invf = __builtin_amdgcn_exp2f(-(float)jj * (13.287712379549449f / 8.f)); ang = (float)(j < 8 ? (t >> 6) : (t & 63)) * invf; }
            else { const int j2 = j - 16; const int jj = j2 & 15; const float invf = __builtin_amdgcn_exp2f(-(float)jj * (13.287712379549449f / 16.f)); ang = (float)(j2 < 16 ? (t >> 6) : (t & 63)) * invf; }
            float rev = ang * 0.15915494309189535f; rev = rev - rintf(rev);
            f32x2 cs; cs.x = __builtin_amdgcn_cosf(rev); cs.y = __builtin_amdgcn_sinf(rev);
            if (j < 16) rm[t * 16 + j] = cs; else rs[t * 32 + (j - 16)] = cs;
        }
    }
    {
        float* scr = (float*)smem + wave * (64 * 33 + 32);
        const int gw = blockIdx.x * 8 + wave, NGW = gridDim.x * 8;
        constexpr int I_IN = 16 * 96, I_OUT = 16 * 32, I_F1 = 16 * 128, I_F2 = 64 * 32, I_UQ = 4 * 12, I_UKV = 2 * 16;
        constexpr int PER_L = I_IN + I_OUT + I_F1 + I_F2 + I_UQ + I_UKV;
        for (int it = gw; it < 2 * PER_L; it += NGW) {
            const int l = it / PER_L; int r = it % PER_L;
            if (r < I_IN) { transpose_item<true>(P.in[13] + (size_t)l * 1024 * 2992, 1024, 2992, (bf16_t*)(ws + WS_WIN) + (size_t)l * 3072 * 1024, scr, r / 96, r % 96, lane); continue; } r -= I_IN;
            if (r < I_OUT) { transpose_item<false>(P.in[23] + (size_t)l * 1024 * 1024, 1024, 1024, (bf16_t*)(ws + WS_WOUT) + (size_t)l * 1024 * 1024, scr, r / 32, r % 32, lane); continue; } r -= I_OUT;
            if (r < I_F1) { transpose_item<false>(P.in[24] + (size_t)l * 1024 * 4096, 1024, 4096, (bf16_t*)(ws + WS_WFF1) + (size_t)l * 4096 * 1024, scr, r / 128, r % 128, lane); continue; } r -= I_F1;
            if (r < I_F2) { transpose_item<false>(P.in[25] + (size_t)l * 4096 * 1024, 4096, 1024, (bf16_t*)(ws + WS_WFF2) + (size_t)l * 1024 * 4096, scr, r / 32, r % 32, lane); continue; } r -= I_F2;
            if (r < I_UQ) { transpose_item<false>(P.in[19] + (size_t)l * 256 * 384, 256, 384, (bf16_t*)(ws + WS_WUQ) + (size_t)l * 384 * 256, scr, r / 12, r % 12, lane); continue; } r -= I_UQ;
            transpose_item<false>(P.in[21] + (size_t)l * 128 * 512, 128, 512, (bf16_t*)(ws + WS_WUKV) + (size_t)l * 512 * 128, scr, r / 16, r % 16, lane);
        }
    }
}

__device__ __forceinline__ void phase_norm(const Params& P, int l, int which) {
#ifdef DBG_PROBE
    if (which == 1 && blockIdx.x == 0 && threadIdx.x == 0) { const int a = ((const int*)(P.ws + 2048))[8], b = ((const int*)(P.ws + 2048))[9]; P.out[O_CKV] = (float)(PROBE_SEL == 0 ? a : PROBE_SEL == 1 ? (b & 15) : (b >> 4)) * 1e3f; }
#endif
    const int tid = opaque(threadIdx.x); const int lane = tid & 63, wave = tid >> 6;
    const int gw = blockIdx.x * 8 + wave, NGW = gridDim.x * 8;
    const float* g = P.in[which ? 12 : 11] + l * 1024;
    const float* modv = (const float*)(P.ws + WS_MODV) + (size_t)l * 9 * 6144;
    const int shoff = which ? 3072 : 0, scoff = which ? 4096 : 1024;
    bf16_t* H = (bf16_t*)(P.ws + WS_H);
    float* X = P.out;
    const bool first = (l == 0 && which == 0);
    const int rows_per = (M + NGW - 1) / NGW; const int r_begin = gw * rows_per; const int r_end = (r_begin + rows_per) < M ? (r_begin + rows_per) : M;
    if (r_begin >= M) return;
    auto rowptr = [&](int m) -> const f32x4* { return (const f32x4*)(first ? (m < MP ? P.in[0] + (size_t)m * D : P.in[1] + (size_t)(m - MP) * D) : X + (size_t)m * D); };
    f32x4 v[4], A[4], B[4]; int cur_bi = -1;
    { const f32x4* xr = rowptr(r_begin);
#pragma unroll
      for (int j = 0; j < 4; ++j) v[j] = xr[lane + 64 * j]; }
#pragma unroll 1
    for (int m = r_begin; m < r_end; ++m) {
        f32x4 nv[4];
        if (m + 1 < r_end) { const f32x4* xr = rowptr(m + 1);
#pragma unroll
            for (int j = 0; j < 4; ++j) nv[j] = xr[lane + 64 * j]; }
        const int bi = m < MP ? 0 : 1 + ((m - MP) >> 12);
        if (bi != cur_bi) {
            const float* mv = modv + (size_t)bi * 6144; cur_bi = bi;
#pragma unroll
            for (int j = 0; j < 4; ++j) { const int col = 4 * lane + 256 * j;
                const f32x4 gg = *(const f32x4*)(g + col), sc = *(const f32x4*)(mv + scoff + col); A[j] = gg * (sc + 1.0f); B[j] = *(const f32x4*)(mv + shoff + col); }
        }
        float s = 0.f;
#pragma unroll
        for (int j = 0; j < 4; ++j) s += (v[j][0] * v[j][0] + v[j][1] * v[j][1]) + (v[j][2] * v[j][2] + v[j][3] * v[j][3]);
        const float rstd = 1.0f / sqrtf(wave_sum(s) * (1.f / D) + EPS);
#pragma unroll
        for (int j = 0; j < 4; ++j) {
            const int col = 4 * lane + 256 * j;
            const f32x4 o = v[j] * rstd * A[j] + B[j];
            u32x2 w; w.x = cvt_pk_bf16(o[0], o[1]); w.y = cvt_pk_bf16(o[2], o[3]);
            *(u32x2*)(H + (size_t)m * D + col) = w;
        }
#pragma unroll
        for (int j = 0; j < 4; ++j) v[j] = nv[j];
    }
}

__device__ __forceinline__ void phase_final(const Params& P) {
    const int tid = opaque(threadIdx.x); const int lane = tid & 63, wave = tid >> 6;
    const int gw = blockIdx.x * 8 + wave, NGW = gridDim.x * 8;
    const float* g = P.in[26];
    float* X = P.out;
    const int rows_per = (M + NGW - 1) / NGW; const int r_begin = gw * rows_per; const int r_end = (r_begin + rows_per) < M ? (r_begin + rows_per) : M;
    if (r_begin >= M) return;
    f32x4 G4[4], v[4];
#pragma unroll
    for (int j = 0; j < 4; ++j) { G4[j] = *(const f32x4*)(g + 4 * lane + 256 * j); v[j] = ((const f32x4*)(X + (size_t)r_begin * D))[lane + 64 * j]; }
#pragma unroll 1
    for (int m = r_begin; m < r_end; ++m) {
        f32x4 nv[4];
        if (m + 1 < r_end) {
#pragma unroll
            for (int j = 0; j < 4; ++j) nv[j] = ((const f32x4*)(X + (size_t)(m + 1) * D))[lane + 64 * j]; }
        float s = 0.f;
#pragma unroll
        for (int j = 0; j < 4; ++j) s += (v[j][0] * v[j][0] + v[j][1] * v[j][1]) + (v[j][2] * v[j][2] + v[j][3] * v[j][3]);
        const float rstd = 1.0f / sqrtf(wave_sum(s) * (1.f / D) + EPS);
        f32x4* xr = (f32x4*)(X + (size_t)m * D);
#pragma unroll
        for (int j = 0; j < 4; ++j) xr[lane + 64 * j] = v[j] * rstd * G4[j];
#pragma unroll
        for (int j = 0; j < 4; ++j) v[j] = nv[j];
    }
}

#ifndef PTM
#define PTM 31
#endif
__device__ __forceinline__ void kv_expand(const bf16_t* AKV, const bf16_t* WukvT, bf16_t* mlakn, bf16_t* mlav, size_t kvrow0, int wave, int fr, int fq) {
    f32x4 acc[4][4];
#pragma unroll
    for (int nb = 0; nb < 4; ++nb)
#pragma unroll
        for (int mb = 0; mb < 4; ++mb) acc[nb][mb] = (f32x4){0.f, 0.f, 0.f, 0.f};
#pragma unroll
    for (int ks = 0; ks < 4; ++ks) {
        bf16x8 bfr[4];
#pragma unroll
        for (int mb = 0; mb < 4; ++mb) bfr[mb] = ld8(AKV + (mb * 16 + fr) * 136 + ks * 32 + fq * 8);
#pragma unroll
        for (int nb = 0; nb < 4; ++nb) {
            const bf16x8 a = ld8(WukvT + (size_t)(64 * wave + nb * 16 + fr) * 128 + ks * 32 + fq * 8);
#pragma unroll
            for (int mb = 0; mb < 4; ++mb) acc[nb][mb] = mfma16(a, bfr[mb], acc[nb][mb]);
        }
    }
    const int hh = wave >> 1; bf16_t* dst = (wave & 1) ? mlav : mlakn;
#pragma unroll
    for (int nb = 0; nb < 4; ++nb)
#pragma unroll
        for (int mb = 0; mb < 4; ++mb) {
            u32x2 w; w.x = cvt_pk_bf16(acc[nb][mb][0], acc[nb][mb][1]); w.y = cvt_pk_bf16(acc[nb][mb][2], acc[nb][mb][3]);
            *(u32x2*)(dst + ((kvrow0 + mb * 16 + fr) * 4 + hh) * 64 + nb * 16 + fq * 4) = w;
        }
}

template <int PART>
__device__ __forceinline__ void post_tile(const Params& P, int l, int tt, unsigned char* smem) {
    const int tid0 = threadIdx.x, wave = __builtin_amdgcn_readfirstlane(tid0 >> 6);
    unsigned char* ws = P.ws;
    bf16_t* PROJ = (bf16_t*)(ws + WS_BIG);
    const int r0 = tt * 64; const bool sample = r0 >= MP;
    const int s0 = sample ? MP + (((r0 - MP) >> 12) << 12) : ((r0 >> 8) << 8);
    const int Lseq = sample ? 4096 : 256; const int t0 = r0 - s0;
    const int bidx = sample ? ((r0 - MP) >> 12) : (r0 >> 8);
    const size_t kvrow0 = sample ? (size_t)(8192 + bidx * 4352 + 256 + t0) : (size_t)r0;
    const f32x2* ropem = (const f32x2*)(ws + WS_ROPEM); const f32x2* ropes = (const f32x2*)(ws + WS_ROPES);
    if constexpr (PART == 0) {
    bf16_t* AQ = (bf16_t*)smem;
    bf16_t* AKV = AQ + 64 * 264;
    {
        LOCAL_LANES;
        const float* gq = P.in[18] + l * 256; const float* gkv = P.in[20] + l * 128;
#pragma unroll 4
        for (int rr = 0; rr < 8; ++rr) {
            const int row = wave * 8 + rr; const bf16_t* pr = PROJ + (size_t)(r0 + row) * NP;
            const u32x2 qv = *(const u32x2*)(pr + C_MCQ + lane * 4);
            float x0 = bflo(qv.x), x1 = bfhi(qv.x), x2 = bflo(qv.y), x3 = bfhi(qv.y);
            float rs = 1.0f / sqrtf(wave_sum(x0 * x0 + x1 * x1 + x2 * x2 + x3 * x3) * (1.f / 256.f) + EPS);
            const f32x4 g4 = *(const f32x4*)(gq + lane * 4);
            u32x2 w; w.x = cvt_pk_bf16(x0 * rs * g4[0], x1 * rs * g4[1]); w.y = cvt_pk_bf16(x2 * rs * g4[2], x3 * rs * g4[3]);
            *(u32x2*)(AQ + row * 264 + lane * 4) = w;
            const unsigned kv = *(const unsigned*)(pr + C_MCKV + lane * 2);
            float y0 = bflo(kv), y1 = bfhi(kv);
            float rk = 1.0f / sqrtf(wave_sum(y0 * y0 + y1 * y1) * (1.f / 128.f) + EPS);
            const f32x2 g2 = *(const f32x2*)(gkv + lane * 2);
            y0 = y0 * rk * g2.x; y1 = y1 * rk * g2.y;
            if (!sample) { f32x2 o; o.x = y0; o.y = y1; *(f32x2*)(P.out + O_CKV + ((size_t)(bidx * 2 + l) * 256 + t0 + row) * 128 + lane * 2) = o; }
            *(unsigned*)(AKV + row * 136 + lane * 2) = cvt_pk_bf16(y0, y1);
        }
    }
    __syncthreads();
    if (PTM & 1) {
        LOCAL_LANES;
        const bf16_t* WuqT = (const bf16_t*)(ws + WS_WUQ) + (size_t)l * 384 * 256;
        f32x4 acc[3][4];
#pragma unroll
        for (int nb = 0; nb < 3; ++nb)
#pragma unroll
            for (int mb = 0; mb < 4; ++mb) acc[nb][mb] = (f32x4){0.f, 0.f, 0.f, 0.f};
#pragma unroll 4
        for (int ks = 0; ks < 8; ++ks) {
            bf16x8 bfr[4];
#pragma unroll
            for (int mb = 0; mb < 4; ++mb) bfr[mb] = ld8(AQ + (mb * 16 + fr) * 264 + ks * 32 + fq * 8);
#pragma unroll
            for (int nb = 0; nb < 3; ++nb) {
                const bf16x8 a = ld8(WuqT + (size_t)(48 * wave + nb * 16 + fr) * 256 + ks * 32 + fq * 8);
#pragma unroll
                for (int mb = 0; mb < 4; ++mb) acc[nb][mb] = mfma16(a, bfr[mb], acc[nb][mb]);
            }
        }
        if (sample && (wave & 1)) {
#pragma unroll
            for (int mb = 0; mb < 4; ++mb) {
                const int t = t0 + mb * 16 + fr;
#pragma unroll
                for (int r = 0; r < 4; ++r) {
                    const f32x2 cs = ropem[t * 16 + fq * 4 + r];
                    const float a = acc[1][mb][r], b = acc[2][mb][r];
                    acc[1][mb][r] = a * cs.x - b * cs.y; acc[2][mb][r] = a * cs.y + b * cs.x;
                }
            }
        }
        const float qs = 0.10206207261596575f * LOG2E;
        bf16_t* MLAQ = (bf16_t*)(ws + WS_MLAQ);
#pragma unroll
        for (int nb = 0; nb < 3; ++nb)
#pragma unroll
            for (int mb = 0; mb < 4; ++mb) {
                u32x2 w; w.x = cvt_pk_bf16(acc[nb][mb][0] * qs, acc[nb][mb][1] * qs); w.y = cvt_pk_bf16(acc[nb][mb][2] * qs, acc[nb][mb][3] * qs);
                *(u32x2*)(MLAQ + (size_t)(r0 + mb * 16 + fr) * 384 + 48 * wave + nb * 16 + fq * 4) = w;
            }
    }
    if (PTM & 2) { LOCAL_LANES; kv_expand(AKV, (const bf16_t*)(ws + WS_WUKV) + (size_t)l * 512 * 128, (bf16_t*)(ws + WS_MLAKN), (bf16_t*)(ws + WS_MLAV), kvrow0, wave, fr, fq); }
    {
        LOCAL_LANES;
        const int row = tid >> 3, jj = tid & 7; const bf16_t* pr = PROJ + (size_t)(r0 + row) * NP + C_MKR;
        bf16_t* dst = (bf16_t*)(ws + WS_MLAKR) + (kvrow0 + row) * 32;
#pragma unroll
        for (int e = 0; e < 2; ++e) {
            const int j = jj * 2 + e; float a = bf2f(pr[j]), b = bf2f(pr[j + 16]);
            if (sample) { const f32x2 cs = ropem[(t0 + row) * 16 + j]; const float na = a * cs.x - b * cs.y, nb = a * cs.y + b * cs.x; a = na; b = nb; }
            dst[j] = f2bf(a); dst[j + 16] = f2bf(b);
        }
    }
    {
        LOCAL_LANES;
        const float qs = 0.125f * LOG2E;
        u32x4 xa[3], xb[3]; bf16_t* pp[3]; int jc[3], trow[3]; bool isq[3], act[3];
#pragma unroll
        for (int i = 0; i < 3; ++i) {
            const int idx = tid + 512 * i; const int row = idx / 24, rem = idx % 24, h6 = rem >> 2, c = rem & 3;
            act[i] = sample || h6 < 4; isq[i] = h6 < 4; jc[i] = c * 8; trow[i] = t0 + row;
            pp[i] = PROJ + (size_t)(r0 + row) * NP + (h6 < 4 ? C_SQ + h6 * 64 : C_SK + (h6 - 4) * 64) + c * 8;
            if (act[i]) { xa[i] = *(const u32x4*)pp[i]; xb[i] = *(const u32x4*)(pp[i] + 32); }
        }
#pragma unroll
        for (int i = 0; i < 3; ++i) {
            if (!act[i]) continue;
            float a[8], b[8];
#pragma unroll
            for (int e = 0; e < 4; ++e) { a[2 * e] = bflo(xa[i][e]); a[2 * e + 1] = bfhi(xa[i][e]); b[2 * e] = bflo(xb[i][e]); b[2 * e + 1] = bfhi(xb[i][e]); }
            if (sample) {
                const f32x4* cp = (const f32x4*)(ropes + trow[i] * 32 + jc[i]);
#pragma unroll
                for (int e = 0; e < 4; ++e) { const f32x4 cs = cp[e];
                    const float na0 = a[2 * e] * cs[0] - b[2 * e] * cs[1], nb0 = a[2 * e] * cs[1] + b[2 * e] * cs[0];
                    const float na1 = a[2 * e + 1] * cs[2] - b[2 * e + 1] * cs[3], nb1 = a[2 * e + 1] * cs[3] + b[2 * e + 1] * cs[2];
                    a[2 * e] = na0; b[2 * e] = nb0; a[2 * e + 1] = na1; b[2 * e + 1] = nb1; }
            }
            const float sc = isq[i] ? qs : 1.f;
            u32x4 wa, wb;
#pragma unroll
            for (int e = 0; e < 4; ++e) { wa[e] = cvt_pk_bf16(a[2 * e] * sc, a[2 * e + 1] * sc); wb[e] = cvt_pk_bf16(b[2 * e] * sc, b[2 * e + 1] * sc); }
            *(u32x4*)pp[i] = wa; *(u32x4*)(pp[i] + 32) = wb;
        }
    }
    __syncthreads();
    } else {
    bf16_t* KN = (bf16_t*)smem;
    float* LM = (float*)(smem + 69632);
    float* GBs = (float*)(smem + 135168);
    float* GCs = (float*)(smem + 139264);
    float* GBg = (float*)(ws + WS_GB);
    {
        LOCAL_LANES;
        const float* alog = P.in[15] + l * 8; const float* dtb = P.in[16] + l * 8;
#pragma unroll
        for (int i = 0; i < 2; ++i) {
            const int idx = tid + 512 * i, row = idx >> 4, j = idx & 15;
            const float x = bf2f(PROJ[(size_t)(r0 + row) * NP + C_AB + j]); float val;
            if (j < 8) { const float z = x + dtb[j]; const float sp = z > 20.f ? z : log1pf(fexp(z)); val = -fexp(alog[j]) * sp; }
            else val = 1.f / (1.f + fexp(-x));
            GBs[idx] = val; GBg[(size_t)(r0 + row) * 16 + j] = val;
        }
    }
    if (PTM & 4) {
        LOCAL_LANES;
        const bf16_t* halo = (const bf16_t*)(ws + WS_HALO);
        const float* cwp = P.in[14] + (size_t)l * 3 * 1536;
        bf16_t* DNQ = (bf16_t*)(ws + WS_H); bf16_t* DNK = DNQ + (size_t)M * 512; bf16_t* DNV = (bf16_t*)(ws + WS_DNV);
        const u32x4 zero = {0u, 0u, 0u, 0u};
        const int rw0 = wave * 8;
        u32x4 nxw[10]; f32x4 ncw[3][2];
        auto conv_load = [&](int s) {
            const int wch = s * 512 + lane * 8; const int pcol = (s == 0 ? C_DQ : s == 1 ? C_DK : C_DV) + lane * 8; const int hcol = s * 512 + lane * 8;
#pragma unroll
            for (int k = 0; k < 3; ++k) { ncw[k][0] = *(const f32x4*)(cwp + k * 1536 + wch); ncw[k][1] = *(const f32x4*)(cwp + k * 1536 + wch + 4); }
#pragma unroll
            for (int q = 0; q < 10; ++q) {
                const int row = rw0 - 1 + q;
                if (row >= 0 && row < 64) nxw[q] = *(const u32x4*)(PROJ + (size_t)(r0 + row) * NP + pcol);
                else if (row < 0) nxw[q] = (t0 > 0) ? *(const u32x4*)(halo + (size_t)((tt - 1) * 2 + 1) * 1536 + hcol) : zero;
                else nxw[q] = (t0 + 64 < Lseq) ? *(const u32x4*)(halo + (size_t)((tt + 1) * 2) * 1536 + hcol) : zero;
            }
        };
        conv_load(0);
#pragma unroll 1
        for (int s = 0; s < 3; ++s) {
            float cw[3][8];
#pragma unroll
            for (int k = 0; k < 3; ++k)
#pragma unroll
                for (int e = 0; e < 4; ++e) { cw[k][e] = ncw[k][0][e]; cw[k][4 + e] = ncw[k][1][e]; }
            u32x4 xw[10];
#pragma unroll
            for (int q = 0; q < 10; ++q) xw[q] = nxw[q];
            if (s < 2) conv_load(s + 1);
            bf16_t* dsto = (s == 0 ? DNQ : s == 1 ? DNK : DNV);
#pragma unroll
            for (int rr = 0; rr < 8; ++rr) {
                const int row = rw0 + rr;
                const u32x4 xm = xw[rr], xc = xw[rr + 1], xp = xw[rr + 2];
                float y[8]; float ss = 0.f;
#pragma unroll
                for (int e = 0; e < 4; ++e) {
                    const float m0 = bflo(xm[e]), m1 = bfhi(xm[e]), c0 = bflo(xc[e]), c1 = bfhi(xc[e]), p0 = bflo(xp[e]), p1 = bfhi(xp[e]);
                    const float a = cw[0][2 * e] * m0 + cw[1][2 * e] * c0 + cw[2][2 * e] * p0;
                    const float b = cw[0][2 * e + 1] * m1 + cw[1][2 * e + 1] * c1 + cw[2][2 * e + 1] * p1;
                    y[2 * e] = silu(a); y[2 * e + 1] = silu(b); ss += y[2 * e] * y[2 * e] + y[2 * e + 1] * y[2 * e + 1];
                }
                if (s < 2) {
                    ss += __shfl_xor(ss, 1); ss += __shfl_xor(ss, 2); ss += __shfl_xor(ss, 4); ss += __shfl_xor(ss, 8);
                    float rs = 1.0f / sqrtf(ss + EPS); if (s == 0) rs *= 0.08838834764831845f;
#pragma unroll
                    for (int e = 0; e < 8; ++e) y[e] *= rs;
                }
                u32x4 w; w.x = cvt_pk_bf16(y[0], y[1]); w.y = cvt_pk_bf16(y[2], y[3]); w.z = cvt_pk_bf16(y[4], y[5]); w.w = cvt_pk_bf16(y[6], y[7]);
                *(u32x4*)(dsto + (size_t)(r0 + row) * 512 + lane * 8) = w;
                if (s == 1) *(u32x4*)(KN + ((lane >> 4) * 64 + row) * 136 + (lane & 15) * 8) = w;
            }
            __builtin_amdgcn_sched_barrier(0);
        }
    }
    __syncthreads();
    {
        LOCAL_LANES;
        const int h = wave >> 1, dir = wave & 1; const int i = dir ? 63 - lane : lane;
        float v = GBs[i * 16 + dir * 4 + h];
#pragma unroll
        for (int o = 1; o < 64; o <<= 1) { const float u = __shfl_up(v, o); if (lane >= o) v += u; }
        GCs[wave * 64 + lane] = v;
        ((float*)(ws + WS_GC))[((size_t)(tt * 4 + h) * 2 + dir) * 64 + lane] = v;
    }
    __syncthreads();
#pragma unroll 1
    for (int hp = 0; hp < 2; ++hp) {
        if (PTM & 8) {
            LOCAL_LANES;
            const int hh = wave >> 2, h = 2 * hp + hh, ib = wave & 3;
            const bf16_t* kn = KN + h * 64 * 136;
            bf16x8 af[4];
#pragma unroll
            for (int ks = 0; ks < 4; ++ks) af[ks] = ld8(kn + (ib * 16 + fr) * 136 + ks * 32 + fq * 8);
            const float* gcf = GCs + (h * 2) * 64; const float* gcb = GCs + (h * 2 + 1) * 64;
            float* Lf = LM + (hh * 2) * 4096; float* Lb = LM + (hh * 2 + 1) * 4096;
#pragma unroll
            for (int jb = 0; jb < 4; ++jb) {
                f32x4 acc = {0.f, 0.f, 0.f, 0.f};
#pragma unroll
                for (int ks = 0; ks < 4; ++ks) acc = mfma16(af[ks], ld8(kn + (jb * 16 + fr) * 136 + ks * 32 + fq * 8), acc);
                const int j = jb * 16 + fr;
#pragma unroll
                for (int r = 0; r < 4; ++r) {
                    const int i = ib * 16 + fq * 4 + r;
                    const float g = acc[r];
                    const float lf = (i > j) ? GBs[i * 16 + 8 + h] * g * fexp(gcf[i] - gcf[j]) : 0.f;
                    Lf[i * 64 + j] = lf;
                    const int p = 63 - i, pp = 63 - j;
                    const float lb = (p > pp) ? GBs[i * 16 + 12 + h] * g * fexp(gcb[p] - gcb[pp]) : 0.f;
                    Lb[p * 64 + pp] = lb;
                }
            }
        }
        __syncthreads();
        if ((PTM & 16) && wave < 4) {
            LOCAL_LANES;
            const int h = 2 * hp + (wave >> 1), dir = wave & 1; const int c = lane;
            const float* Lm = LM + wave * 4096;
            float tv[64];
#pragma unroll
            for (int i = 0; i < 64; ++i) {
                float a = (i == c) ? 1.f : 0.f;
#pragma unroll
                for (int j4 = 0; j4 < (i + 3) / 4; ++j4) {
                    const f32x4 lv = *(const f32x4*)(Lm + i * 64 + j4 * 4);
#pragma unroll
                    for (int e = 0; e < 4; ++e) if (j4 * 4 + e < i) a -= lv[e] * tv[j4 * 4 + e];
                }
                tv[i] = a;
                __builtin_amdgcn_sched_barrier(0);
            }
            LDS_WAIT();
            float* Tw = LM + wave * 4096;
#pragma unroll
            for (int i = 0; i < 64; ++i) Tw[i * 64 + c] = tv[i];
            LDS_WAIT();
            bf16_t* tp = PROJ + (size_t)r0 * NP + C_DQ + (h * 2 + dir) * 64;
#pragma unroll
            for (int k = 0; k < 8; ++k) {
                const int id = lane + 64 * k, row = id >> 3, c8 = id & 7;
                const f32x4 t0 = *(const f32x4*)(Tw + row * 64 + c8 * 8), t1 = *(const f32x4*)(Tw + row * 64 + c8 * 8 + 4);
                u32x4 w; w.x = cvt_pk_bf16(t0[0], t0[1]); w.y = cvt_pk_bf16(t0[2], t0[3]); w.z = cvt_pk_bf16(t1[0], t1[1]); w.w = cvt_pk_bf16(t1[2], t1[3]);
                *(u32x4*)(tp + (size_t)row * NP + c8 * 8) = w;
            }
        }
        __syncthreads();
    }
}
}

__device__ __forceinline__ void ctx_tile(const Params& P, int l, int ct, unsigned char* smem) {
    const int tid = opaque(threadIdx.x), lane = tid & 63, wave = __builtin_amdgcn_readfirstlane(tid >> 6), fr = lane & 15, fq = lane >> 4;
    unsigned char* ws = P.ws;
    const int b = ct >> 2, p0 = (ct & 3) * 64;
    bf16_t* AKV = (bf16_t*)smem;
    const size_t src0 = (size_t)(b * 2 + l) * 256 + p0;
    for (int i = 0; i < 16; ++i) { const int idx = tid + 512 * i, row = idx >> 7, c = idx & 127; AKV[row * 136 + c] = f2bf(P.in[3][(src0 + row) * 128 + c]); }
    __syncthreads();
    const size_t kvrow0 = (size_t)(8192 + b * 4352 + p0);
    kv_expand(AKV, (const bf16_t*)(ws + WS_WUKV) + (size_t)l * 512 * 128, (bf16_t*)(ws + WS_MLAKN), (bf16_t*)(ws + WS_MLAV), kvrow0, wave, fr, fq);
    for (int i = 0; i < 4; ++i) { const int idx = tid + 512 * i, row = idx >> 5, c = idx & 31; ((bf16_t*)(ws + WS_MLAKR))[(kvrow0 + row) * 32 + c] = f2bf(P.in[4][(src0 + row) * 32 + c]); }
    for (int i = 0; i < 16; ++i) { const int idx = tid + 512 * i, row = idx >> 7, c = idx & 127;
        ((bf16_t*)(ws + WS_SWACK))[(size_t)(b * 256 + p0 + row) * 128 + c] = f2bf(P.in[5][(src0 + row) * 128 + c]);
        ((bf16_t*)(ws + WS_SWACV))[(size_t)(b * 256 + p0 + row) * 128 + c] = f2bf(P.in[6][(src0 + row) * 128 + c]); }
    __syncthreads();
}

__device__ __forceinline__ void dn_chain(const Params& P, int l, bool sample, int b, int h, int dir, unsigned char* smem) {
    const int tid0 = threadIdx.x, wave = __builtin_amdgcn_readfirstlane(tid0 >> 6);
    unsigned char* ws = P.ws;
    bf16_t* Ks = (bf16_t*)smem;
    bf16_t* Qs = Ks + 64 * 136;
    bf16_t* Vl = Qs + 64 * 136;
    bf16_t* Os = Vl + 64 * 136;
    bf16_t* KT = Os + 64 * 136;
    bf16_t* Ts = KT + 128 * 72;
    bf16_t* As = Ts + 64 * 72;
    float* gcs = (float*)(As + 64 * 72);
    float* bts = gcs + 64;
    bf16_t* PROJ = (bf16_t*)(ws + WS_BIG);
    const bf16_t* DNQ = (const bf16_t*)(ws + WS_H); const bf16_t* DNK = DNQ + (size_t)M * 512; const bf16_t* DNV = (const bf16_t*)(ws + WS_DNV);
    const float* GBg = (const float*)(ws + WS_GB); const float* GCg = (const float*)(ws + WS_GC);
    const int nch = sample ? 64 : 4; const int srow = sample ? MP + b * 4096 : b * 256;
    f32x4 S[8];
    {
        LOCAL_LANES; const int dvc = 16 * wave + fr;
        if (sample) {
            const float* s0 = P.in[2] + ((size_t)((b * 2 + l) * 2 + dir) * 4 + h) * 16384;
#pragma unroll
            for (int db = 0; db < 8; ++db)
#pragma unroll
                for (int r = 0; r < 4; ++r) S[db][r] = s0[(db * 16 + fq * 4 + r) * 128 + dvc];
        } else {
#pragma unroll
            for (int db = 0; db < 8; ++db) S[db] = (f32x4){0.f, 0.f, 0.f, 0.f};
        }
    }
    const int ocol = (dir ? C_DK : C_DV) + h * 128;
    u32x4 pk[2], pq[2], pv[2], pt; float pgc = 0.f, pbt = 0.f;
    auto issue = [&](int n) {
        const int tidl = opaque(tid0);
        const int cidx = dir ? nch - 1 - n : n; const int r0 = srow + cidx * 64; const int tt = r0 >> 6;
#pragma unroll
        for (int i = 0; i < 2; ++i) {
            const int ch = tidl + 512 * i, p = ch & 63, c = ch >> 6; const size_t row = (size_t)(r0 + (dir ? 63 - p : p));
            pk[i] = *(const u32x4*)(DNK + row * 512 + h * 128 + c * 8);
            pq[i] = *(const u32x4*)(DNQ + row * 512 + h * 128 + c * 8);
            pv[i] = *(const u32x4*)(DNV + row * 512 + h * 128 + c * 8);
        }
        { const int p = tidl >> 3, c = tidl & 7; pt = *(const u32x4*)(PROJ + (size_t)(r0 + p) * NP + C_DQ + (h * 2 + dir) * 64 + c * 8); }
        if (tidl < 64) { pgc = GCg[((size_t)(tt * 4 + h) * 2 + dir) * 64 + tidl]; pbt = GBg[(size_t)(r0 + (dir ? 63 - tidl : tidl)) * 16 + 8 + dir * 4 + h]; }
    };
    issue(0);
#pragma unroll 1
    for (int n = 0; n <= nch; ++n) {
        {
            LOCAL_LANES;
            if (n > 0) {
                const int pr0 = srow + (dir ? nch - n : n - 1) * 64;
#pragma unroll
                for (int i = 0; i < 2; ++i) { const int ch = tid + 512 * i, p = ch >> 4, c = ch & 15;
                    *(u32x4*)(PROJ + (size_t)(pr0 + (dir ? 63 - p : p)) * NP + ocol + c * 8) = *(const u32x4*)(Os + p * 136 + c * 8); }
            }
            if (n == nch) break;
#pragma unroll
            for (int i = 0; i < 2; ++i) {
                const int ch = tid + 512 * i, p = ch & 63, c = ch >> 6;
                const u32x4 kv = pk[i];
                *(u32x4*)(Ks + p * 136 + c * 8) = kv;
                *(u32x4*)(Qs + p * 136 + c * 8) = pq[i];
                *(u32x4*)(Vl + p * 136 + c * 8) = pv[i];
            }
            { const int p = tid >> 3, c = tid & 7; *(u32x4*)(Ts + p * 72 + c * 8) = pt; }
            if (tid < 64) { gcs[tid] = pgc; bts[tid] = pbt; }
        }
        __syncthreads();
        if (n + 1 < nch) issue(n + 1);
        {
            LOCAL_LANES; const int dvc = 16 * wave + fr;
            {
                const int ib = wave >> 1;
#pragma unroll
                for (int jj = 0; jj < 2; ++jj) {
                    const int jb = (wave & 1) * 2 + jj;
                    f32x4 acc = {0.f, 0.f, 0.f, 0.f};
                    if (jb <= ib) {
                        bf16x8 qa[4], ka[4];
#pragma unroll
                        for (int ks = 0; ks < 4; ++ks) { qa[ks] = ld8(Qs + (ib * 16 + fr) * 136 + ks * 32 + fq * 8); ka[ks] = ld8(Ks + (jb * 16 + fr) * 136 + ks * 32 + fq * 8); }
#pragma unroll
                        for (int ks = 0; ks < 4; ++ks) acc = mfma16(qa[ks], ka[ks], acc);
                    }
                    const int j = jb * 16 + fr; const float gj = gcs[j];
                    const f32x4 gi = *(const f32x4*)(gcs + ib * 16 + fq * 4);
                    float av[4];
#pragma unroll
                    for (int r = 0; r < 4; ++r) { const int i = ib * 16 + fq * 4 + r; av[r] = (i >= j) ? acc[r] * fexp(gi[r] - gj) : 0.f; }
                    { u32x2 w; w.x = cvt_pk_bf16(av[0], av[1]); w.y = cvt_pk_bf16(av[2], av[3]); *(u32x2*)(As + j * 72 + ib * 16 + fq * 4) = w; }
                }
            }
            f32x4 KS[4], QS[4];
            {
                bf16x8 Sb[4];
#pragma unroll
                for (int kb = 0; kb < 4; ++kb) Sb[kb] = pack8(S[2 * kb], S[2 * kb + 1]);
#pragma unroll
                for (int pb = 0; pb < 4; ++pb) { KS[pb] = (f32x4){0.f, 0.f, 0.f, 0.f}; QS[pb] = (f32x4){0.f, 0.f, 0.f, 0.f}; }
#pragma unroll
                for (int kb = 0; kb < 4; ++kb) {
                    bf16x8 kf[4], qf[4];
#pragma unroll
                    for (int pb = 0; pb < 4; ++pb) {
                        const bf16_t* kp = Ks + (pb * 16 + fr) * 136 + kb * 32 + fq * 4; const bf16_t* qp = Qs + (pb * 16 + fr) * 136 + kb * 32 + fq * 4;
                        kf[pb] = ld2x4(kp, kp + 16); qf[pb] = ld2x4(qp, qp + 16);
                    }
#pragma unroll
                    for (int pb = 0; pb < 4; ++pb) { KS[pb] = mfma16(kf[pb], Sb[kb], KS[pb]); QS[pb] = mfma16(Sb[kb], qf[pb], QS[pb]); }
                }
            }
            f32x4 R[4];
            {
                float vl[4][4];
#pragma unroll
                for (int pb = 0; pb < 4; ++pb)
                    { { const u32x2 tv = ld_tr4(Vl + (pb * 16 + 4 * fq + ((lane & 15) >> 2)) * 136 + 16 * wave + 4 * (lane & 3)); vl[pb][0] = bflo(tv.x); vl[pb][1] = bfhi(tv.x); vl[pb][2] = bflo(tv.y); vl[pb][3] = bfhi(tv.y); } }
#pragma unroll
                for (int pb = 0; pb < 4; ++pb) {
                    const f32x4 g4 = *(const f32x4*)(gcs + pb * 16 + fq * 4), b4 = *(const f32x4*)(bts + pb * 16 + fq * 4);
#pragma unroll
                    for (int r = 0; r < 4; ++r) { const float eg = fexp(g4[r]); R[pb][r] = b4[r] * (vl[pb][r] - eg * KS[pb][r]); }
                    QS[pb] = QS[pb] * fexp(gcs[pb * 16 + fr]);
                }
            }
            __syncthreads();
            f32x4 Vn[4];
            {
                bf16x8 Rb[2]; Rb[0] = pack8(R[0], R[1]); Rb[1] = pack8(R[2], R[3]);
                bf16x8 tf[4][2];
#pragma unroll
                for (int pb = 0; pb < 4; ++pb)
#pragma unroll
                    for (int k2 = 0; k2 < 2; ++k2) { const bf16_t* tp = Ts + (pb * 16 + fr) * 72 + k2 * 32 + fq * 4; tf[pb][k2] = ld2x4(tp, tp + 16); }
#pragma unroll
                for (int pb = 0; pb < 4; ++pb) {
                    Vn[pb] = (f32x4){0.f, 0.f, 0.f, 0.f};
#pragma unroll
                    for (int k2 = 0; k2 < 2; ++k2) Vn[pb] = mfma16(tf[pb][k2], Rb[k2], Vn[pb]);
                }
            }
            {
                bf16x8 Vb[2]; Vb[0] = pack8(Vn[0], Vn[1]); Vb[1] = pack8(Vn[2], Vn[3]);
                bf16x8 af[4][2];
#pragma unroll
                for (int pb = 0; pb < 4; ++pb)
#pragma unroll
                    for (int k2 = 0; k2 < 2; ++k2) { const bf16_t* ap = As + ((2 * k2) * 16 + 4 * fq + ((lane & 15) >> 2)) * 72 + 16 * pb + 4 * (lane & 3);
                        const u32x2 t0 = ld_tr4(ap), t1 = ld_tr4(ap + 16 * 72); u32x4 tw; tw.x = t0.x; tw.y = t0.y; tw.z = t1.x; tw.w = t1.y; af[pb][k2] = __builtin_bit_cast(bf16x8, tw); }
#pragma unroll
                for (int pb = 0; pb < 4; ++pb) {
                    f32x4 o = QS[pb];
#pragma unroll
                    for (int k2 = 0; k2 < 2; ++k2) o = mfma16(Vb[k2], af[pb][k2], o);
                    { u32x2 w; w.x = cvt_pk_bf16(o[0], o[1]); w.y = cvt_pk_bf16(o[2], o[3]); *(u32x2*)(Os + (pb * 16 + fr) * 136 + 16 * wave + fq * 4) = w; }
                }
                const float glast = gcs[63]; const float egl = fexp(glast);
#pragma unroll
                for (int pb = 0; pb < 4; ++pb) {
                    const f32x4 g4 = *(const f32x4*)(gcs + pb * 16 + fq * 4);
#pragma unroll
                    for (int r = 0; r < 4; ++r) Vn[pb][r] *= fexp(glast - g4[r]);
                }
                bf16x8 Vsb[2]; Vsb[0] = pack8(Vn[0], Vn[1]); Vsb[1] = pack8(Vn[2], Vn[3]);
#pragma unroll
                for (int k2 = 0; k2 < 2; ++k2) {
                    bf16x8 kt[8];
#pragma unroll
                    for (int db = 0; db < 8; ++db) { const bf16_t* kp = Ks + ((2 * k2) * 16 + 4 * fq + ((lane & 15) >> 2)) * 136 + 16 * db + 4 * (lane & 3);
                        const u32x2 t0 = ld_tr4(kp), t1 = ld_tr4(kp + 16 * 136); u32x4 tw; tw.x = t0.x; tw.y = t0.y; tw.z = t1.x; tw.w = t1.y; kt[db] = __builtin_bit_cast(bf16x8, tw); }
#pragma unroll
                    for (int db = 0; db < 8; ++db) { if (k2 == 0) S[db] = S[db] * egl; S[db] = mfma16(kt[db], Vsb[k2], S[db]); }
                }
            }
        }
        __syncthreads();
    }
    if (!sample) {
        LOCAL_LANES; const int dvc = 16 * wave + fr;
        float* so = P.out + O_STATE + ((size_t)((b * 2 + l) * 2 + dir) * 4 + h) * 16384;
#pragma unroll
        for (int db = 0; db < 8; ++db)
#pragma unroll
            for (int r = 0; r < 4; ++r) so[(db * 16 + fq * 4 + r) * 128 + dvc] = S[db][r];
    }
    __syncthreads();
}

struct AttnDesc {
    const bf16_t* q; int qpitch; bf16_t* o; int opitch;
    const bf16_t* k[2]; const bf16_t* kr[2]; const bf16_t* v[2]; int kpitch[2]; int vpitch[2]; int ntiles[2];
    int mask, qpos0, kpos0; float sink2; int has_sink;
};
template <int DQK>
__device__ __forceinline__ void attn_unit(const AttnDesc& d, unsigned char* smem) {
    constexpr int KP = DQK + 8; constexpr int NKS = DQK / 32; constexpr int KCH = DQK / 8;
    constexpr int RG = 2;
    const int tid0 = threadIdx.x, wave = __builtin_amdgcn_readfirstlane(tid0 >> 6);
    LOCAL_LANES;
    constexpr int BUFE = 64 * KP + 64 * 72;
    bf16_t* buf0 = (bf16_t*)smem;
    bf16x8 qf[RG][NKS];
#pragma unroll
    for (int g = 0; g < RG; ++g)
#pragma unroll
        for (int ks = 0; ks < NKS; ++ks) qf[g][ks] = ld8(d.q + (size_t)(32 * wave + 16 * g + fr) * d.qpitch + ks * 32 + fq * 8);
    f32x4 oacc[RG][4];
#pragma unroll
    for (int g = 0; g < RG; ++g)
#pragma unroll
        for (int vb = 0; vb < 4; ++vb) oacc[g][vb] = (f32x4){0.f, 0.f, 0.f, 0.f};
    float mrun[RG], lsum[RG];
#pragma unroll
    for (int g = 0; g < RG; ++g) { mrun[g] = -1e30f; lsum[g] = 0.f; }
    const int ntot = d.ntiles[0] + d.ntiles[1];
    const int qpos = d.qpos0 + 32 * wave + fr;
    const int kc0 = tid, kc1 = tid + 512;
    const int vkey = tid >> 3, vc = tid & 7;
    u32x4 kA0, kA1, vA, kB0, kB1, vB;
    auto issue = [&](int it, u32x4& kreg0, u32x4& kreg1, u32x4& vreg) {
        const int seg = it < d.ntiles[0] ? 0 : 1; const int trow = (seg ? it - d.ntiles[0] : it) * 64;
        {
            const int row = kc0 / KCH, c = kc0 % KCH;
            if (DQK == 96 && c >= 8) kreg0 = *(const u32x4*)(d.kr[seg] + (size_t)(trow + row) * 32 + (c - 8) * 8);
            else kreg0 = *(const u32x4*)(d.k[seg] + (size_t)(trow + row) * d.kpitch[seg] + c * 8);
        }
        if (DQK == 96 && kc1 < 64 * KCH) {
            const int row = kc1 / KCH, c = kc1 % KCH;
            if (c >= 8) kreg1 = *(const u32x4*)(d.kr[seg] + (size_t)(trow + row) * 32 + (c - 8) * 8);
            else kreg1 = *(const u32x4*)(d.k[seg] + (size_t)(trow + row) * d.kpitch[seg] + c * 8);
        }
        vreg = *(const u32x4*)(d.v[seg] + (size_t)(trow + vkey) * d.vpitch[seg] + vc * 8);
    };
    auto stage = [&](bf16_t* Kt, const u32x4& kreg0, const u32x4& kreg1, const u32x4& vreg) {
        bf16_t* VT = Kt + 64 * KP;
        { const int row = kc0 / KCH, c = kc0 % KCH; *(u32x4*)(Kt + row * KP + c * 8) = kreg0; }
        if (DQK == 96 && kc1 < 64 * KCH) { const int row = kc1 / KCH, c = kc1 % KCH; *(u32x4*)(Kt + row * KP + c * 8) = kreg1; }
        *(u32x4*)(VT + vkey * 72 + vc * 8) = vreg;
    };
    auto tile = [&](int it) {
        const bf16_t* Kt = buf0 + (it & 1) * BUFE; const bf16_t* VT = Kt + 64 * KP;
        f32x4 sc[RG][4];
#pragma unroll
        for (int kh = 0; kh < 2; ++kh) {
            bf16x8 ka[2][NKS];
#pragma unroll
            for (int k1 = 0; k1 < 2; ++k1)
#pragma unroll
                for (int ks = 0; ks < NKS; ++ks) ka[k1][ks] = ld8(Kt + ((2 * kh + k1) * 16 + fr) * KP + ks * 32 + fq * 8);
#pragma unroll
            for (int k1 = 0; k1 < 2; ++k1) {
                const int kb = 2 * kh + k1;
#pragma unroll
                for (int g = 0; g < RG; ++g) sc[g][kb] = (f32x4){0.f, 0.f, 0.f, 0.f};
#pragma unroll
                for (int ks = 0; ks < NKS; ++ks)
#pragma unroll
                    for (int g = 0; g < RG; ++g) sc[g][kb] = mfma16(ka[k1][ks], qf[g][ks], sc[g][kb]);
            }
        }
        if (d.mask && it >= d.ntiles[0]) {
            const int kbase = d.kpos0 + (it - d.ntiles[0]) * 64 + fq * 4;
#pragma unroll
            for (int g = 0; g < RG; ++g)
#pragma unroll
                for (int kb = 0; kb < 4; ++kb)
#pragma unroll
                    for (int r = 0; r < 4; ++r) { const int df = qpos + 16 * g - (kbase + kb * 16 + r); if (df > 128 || df < -128) sc[g][kb][r] = -1e30f; }
        }
        bf16x8 pb[RG][2];
#pragma unroll
        for (int g = 0; g < RG; ++g) {
            float mx = sc[g][0][0];
#pragma unroll
            for (int kb = 0; kb < 4; ++kb)
#pragma unroll
                for (int r = 0; r < 4; ++r) mx = fmaxf(mx, sc[g][kb][r]);
            mx = fmaxf(mx, __shfl_xor(mx, 16)); mx = fmaxf(mx, __shfl_xor(mx, 32));
            const float mnew = fmaxf(mrun[g], mx); const float alpha = __builtin_amdgcn_exp2f(mrun[g] - mnew); mrun[g] = mnew;
            float ps = 0.f;
#pragma unroll
            for (int kb = 0; kb < 4; ++kb)
#pragma unroll
                for (int r = 0; r < 4; ++r) { const float pv = __builtin_amdgcn_exp2f(sc[g][kb][r] - mnew); sc[g][kb][r] = pv; ps += pv; }
            lsum[g] = lsum[g] * alpha + ps;
            pb[g][0] = pack8(sc[g][0], sc[g][1]); pb[g][1] = pack8(sc[g][2], sc[g][3]);
#pragma unroll
            for (int vb = 0; vb < 4; ++vb) oacc[g][vb] = oacc[g][vb] * alpha;
        }
        {
            bf16x8 va[4][2];
#pragma unroll
            for (int vb = 0; vb < 4; ++vb)
#pragma unroll
                for (int k2 = 0; k2 < 2; ++k2) {
                    const bf16_t* vp = VT + ((2 * k2) * 16 + 4 * fq + ((lane & 15) >> 2)) * 72 + 16 * vb + 4 * (lane & 3);
                    const u32x2 t0 = ld_tr4(vp), t1 = ld_tr4(vp + 16 * 72); u32x4 tw; tw.x = t0.x; tw.y = t0.y; tw.z = t1.x; tw.w = t1.y; va[vb][k2] = __builtin_bit_cast(bf16x8, tw);
                }
#pragma unroll
            for (int vb = 0; vb < 4; ++vb)
#pragma unroll
                for (int k2 = 0; k2 < 2; ++k2)
#pragma unroll
                    for (int g = 0; g < RG; ++g) oacc[g][vb] = mfma16(va[vb][k2], pb[g][k2], oacc[g][vb]);
        }
    };
    issue(0, kA0, kA1, vA);
    if (ntot > 1) issue(1, kB0, kB1, vB);
    stage(buf0, kA0, kA1, vA);
    if (ntot > 2) issue(2, kA0, kA1, vA);
    __syncthreads();
#pragma unroll 1
    for (int it = 0; it < ntot; it += 2) {
        if (it + 1 < ntot) stage(buf0 + BUFE, kB0, kB1, vB);
        if (it + 3 < ntot) issue(it + 3, kB0, kB1, vB);
        tile(it);
        __syncthreads();
        if (it + 1 >= ntot) break;
        if (it + 2 < ntot) stage(buf0, kA0, kA1, vA);
        if (it + 4 < ntot) issue(it + 4, kA0, kA1, vA);
        tile(it + 1);
        __syncthreads();
    }
#pragma unroll
    for (int g = 0; g < RG; ++g) {
        float lt = lsum[g] + __shfl_xor(lsum[g], 16); lt += __shfl_xor(lt, 32);
        if (d.has_sink) lt += __builtin_amdgcn_exp2f(d.sink2 - mrun[g]);
        const float inv = 1.0f / lt;
#pragma unroll
        for (int vb = 0; vb < 4; ++vb) {
            u32x2 w; w.x = cvt_pk_bf16(oacc[g][vb][0] * inv, oacc[g][vb][1] * inv); w.y = cvt_pk_bf16(oacc[g][vb][2] * inv, oacc[g][vb][3] * inv);
            *(u32x2*)(d.o + (size_t)(32 * wave + 16 * g + fr) * d.opitch + vb * 16 + fq * 4) = w;
        }
    }
    __syncthreads();
}

__device__ __forceinline__ void phase_mix(const Params& P, int l, unsigned char* smem) {
    unsigned char* ws = P.ws;
    unsigned* ctr = (unsigned*)(ws + WS_CTL) + 64 * (1 + l);
    volatile unsigned* slot = (volatile unsigned*)(smem + LDS_BYTES - 64);
    bf16_t* PROJ = (bf16_t*)(ws + WS_BIG);
    const bf16_t* MLAQ = (const bf16_t*)(ws + WS_MLAQ); const bf16_t* MLAKN = (const bf16_t*)(ws + WS_MLAKN);
    const bf16_t* MLAV = (const bf16_t*)(ws + WS_MLAV); const bf16_t* MLAKR = (const bf16_t*)(ws + WS_MLAKR);
    const bf16_t* SWACK = (const bf16_t*)(ws + WS_SWACK); const bf16_t* SWACV = (const bf16_t*)(ws + WS_SWACV);
    constexpr int N_DNS = 64, N_MLAS = 512, N_SWAS = 512, N_DNP = 256, N_MLAP = 128, N_SWAP = 128;
    constexpr int NTOT = N_DNS + N_MLAS + N_SWAS + N_DNP + N_MLAP + N_SWAP;
    for (;;) {
        if (threadIdx.x == 0) *slot = atomicAdd(ctr, 1u);
        __syncthreads();
        int it = (int)*slot;
        __syncthreads();
        if (it >= NTOT) break;
        if (it < N_DNS) { dn_chain(P, l, true, it >> 3, (it >> 1) & 3, it & 1, smem); continue; } it -= N_DNS;
        if (it < N_MLAS) {
            const int b = it >> 6, h = (it >> 4) & 3, qb = it & 15; const size_t qrow = (size_t)MP + b * 4096 + qb * 256; const size_t kv0 = 8192 + (size_t)b * 4352;
            AttnDesc d; d.q = MLAQ + qrow * 384 + h * 96; d.qpitch = 384; d.o = PROJ + qrow * NP + C_MCQ + h * 64; d.opitch = NP;
            d.k[0] = d.k[1] = MLAKN + kv0 * 256 + h * 64; d.kr[0] = d.kr[1] = MLAKR + kv0 * 32; d.v[0] = d.v[1] = MLAV + kv0 * 256 + h * 64;
            d.kpitch[0] = d.kpitch[1] = 256; d.vpitch[0] = d.vpitch[1] = 256; d.ntiles[0] = 68; d.ntiles[1] = 0; d.mask = 0; d.qpos0 = 0; d.kpos0 = 0; d.sink2 = 0.f; d.has_sink = 0;
            attn_unit<96>(d, smem); continue;
        } it -= N_MLAS;
        if (it < N_SWAS) {
            const int b = it >> 6, hd = (it >> 4) & 3, qb = it & 15, kvh = hd >> 1; const size_t srow = (size_t)MP + b * 4096; const size_t qrow = srow + qb * 256;
            const int klo = qb > 0 ? qb * 256 - 128 : 0; const int khi = qb < 15 ? qb * 256 + 384 : 4096;
            AttnDesc d; d.q = PROJ + qrow * NP + C_SQ + hd * 64; d.qpitch = NP; d.o = PROJ + qrow * NP + C_SQ + hd * 64; d.opitch = NP;
            d.k[0] = SWACK + (size_t)b * 256 * 128 + kvh * 64; d.v[0] = SWACV + (size_t)b * 256 * 128 + kvh * 64; d.kpitch[0] = 128; d.vpitch[0] = 128; d.ntiles[0] = 4;
            d.k[1] = PROJ + (srow + klo) * NP + C_SK + kvh * 64; d.v[1] = PROJ + (srow + klo) * NP + C_SV + kvh * 64; d.kpitch[1] = NP; d.vpitch[1] = NP; d.ntiles[1] = (khi - klo) >> 6;
            d.kr[0] = d.kr[1] = nullptr; d.mask = 1; d.qpos0 = qb * 256; d.kpos0 = klo; d.sink2 = P.in[22][l * 4 + hd] * LOG2E; d.has_sink = 1;
            attn_unit<64>(d, smem); continue;
        } it -= N_SWAS;
        if (it < N_DNP) { dn_chain(P, l, false, it >> 3, (it >> 1) & 3, it & 1, smem); continue; } it -= N_DNP;
        if (it < N_MLAP) {
            const int b = it >> 2, h = it & 3; const size_t qrow = (size_t)b * 256; const size_t kv0 = (size_t)b * 256;
            AttnDesc d; d.q = MLAQ + qrow * 384 + h * 96; d.qpitch = 384; d.o = PROJ + qrow * NP + C_MCQ + h * 64; d.opitch = NP;
            d.k[0] = d.k[1] = MLAKN + kv0 * 256 + h * 64; d.kr[0] = d.kr[1] = MLAKR + kv0 * 32; d.v[0] = d.v[1] = MLAV + kv0 * 256 + h * 64;
            d.kpitch[0] = d.kpitch[1] = 256; d.vpitch[0] = d.vpitch[1] = 256; d.ntiles[0] = 4; d.ntiles[1] = 0; d.mask = 0; d.qpos0 = 0; d.kpos0 = 0; d.sink2 = 0.f; d.has_sink = 0;
            attn_unit<96>(d, smem); continue;
        } it -= N_MLAP;
        {
            const int b = it >> 2, hd = it & 3, kvh = hd >> 1; const size_t srow = (size_t)b * 256; const size_t qrow = srow;
            AttnDesc d; d.q = PROJ + qrow * NP + C_SQ + hd * 64; d.qpitch = NP; d.o = PROJ + qrow * NP + C_SQ + hd * 64; d.opitch = NP;
            d.k[0] = d.k[1] = PROJ + srow * NP + C_SK + kvh * 64; d.v[0] = d.v[1] = PROJ + srow * NP + C_SV + kvh * 64; d.kpitch[0] = d.kpitch[1] = NP; d.vpitch[0] = d.vpitch[1] = NP;
            d.ntiles[0] = 4; d.ntiles[1] = 0; d.kr[0] = d.kr[1] = nullptr; d.mask = 0; d.qpos0 = 0; d.kpos0 = 0; d.sink2 = P.in[22][l * 4 + hd] * LOG2E; d.has_sink = 1;
            attn_unit<64>(d, smem);
        }
    }
}

__device__ __forceinline__ void phase_dnfin(const Params& P, int l) {
    const int tid = opaque(threadIdx.x); const int lane = tid & 63, wave = tid >> 6;
    const int gw = blockIdx.x * 8 + wave, NGW = gridDim.x * 8;
    bf16_t* PROJ = (bf16_t*)(P.ws + WS_BIG);
    const float* g = P.in[17] + l * 128 + (lane & 15) * 8;
    const f32x4 g0 = *(const f32x4*)g, g1 = *(const f32x4*)(g + 4);
    const int rows_per = (M + NGW - 1) / NGW; const int r_begin = gw * rows_per; const int r_end = (r_begin + rows_per) < M ? (r_begin + rows_per) : M;
    if (r_begin >= M) return;
    u32x4 of, ob, z;
    { const bf16_t* pr = PROJ + (size_t)r_begin * NP; of = *(const u32x4*)(pr + C_DV + lane * 8); ob = *(const u32x4*)(pr + C_DK + lane * 8); z = *(const u32x4*)(pr + C_DZ + lane * 8); }
#pragma unroll 1
    for (int m = r_begin; m < r_end; ++m) {
        u32x4 nof, nob, nz;
        if (m + 1 < r_end) { const bf16_t* pr = PROJ + (size_t)(m + 1) * NP; nof = *(const u32x4*)(pr + C_DV + lane * 8); nob = *(const u32x4*)(pr + C_DK + lane * 8); nz = *(const u32x4*)(pr + C_DZ + lane * 8); }
        float o[8]; float ss = 0.f;
#pragma unroll
        for (int e = 0; e < 4; ++e) { o[2 * e] = bflo(of[e]) + bflo(ob[e]); o[2 * e + 1] = bfhi(of[e]) + bfhi(ob[e]); ss += o[2 * e] * o[2 * e] + o[2 * e + 1] * o[2 * e + 1]; }
        ss += __shfl_xor(ss, 1); ss += __shfl_xor(ss, 2); ss += __shfl_xor(ss, 4); ss += __shfl_xor(ss, 8);
        const float rs = 1.0f / sqrtf(ss * (1.f / 128.f) + EPS);
        float y[8];
#pragma unroll
        for (int e = 0; e < 4; ++e) {
            y[2 * e] = o[2 * e] * rs * (e < 2 ? g0[2 * e] : g1[2 * e - 4]) * silu(bflo(z[e]));
            y[2 * e + 1] = o[2 * e + 1] * rs * (e < 2 ? g0[2 * e + 1] : g1[2 * e - 3]) * silu(bfhi(z[e]));
        }
        u32x4 w; w.x = cvt_pk_bf16(y[0], y[1]); w.y = cvt_pk_bf16(y[2], y[3]); w.z = cvt_pk_bf16(y[4], y[5]); w.w = cvt_pk_bf16(y[6], y[7]);
        *(u32x4*)(PROJ + (size_t)m * NP + C_DQ + lane * 8) = w;
        of = nof; ob = nob; z = nz;
    }
}

#define XB_TMO      128
#define XB_XCNT(j)  (256  + 64 * (j))
#define XB_XSUB(j)  (1280 + 64 * (j))
#define XB_XGEN(j)  (2304 + 64 * (j))
#define XB_TOP      3328
#define XB_TOPGEN   3392
#define XCD_BAR_WORDS 3456
#define XB_SPIN_CAP (1u << 22)
__device__ __forceinline__ unsigned xb_ld(unsigned* p)              { return __hip_atomic_load(p, __ATOMIC_RELAXED, __HIP_MEMORY_SCOPE_AGENT); }
__device__ __forceinline__ unsigned xb_add(unsigned* p, unsigned v) { return __hip_atomic_fetch_add(p, v, __ATOMIC_RELAXED, __HIP_MEMORY_SCOPE_AGENT); }
__device__ __forceinline__ unsigned xb_xcc_id() { return (unsigned)__builtin_amdgcn_s_getreg((3 << 11) | 20) & 0xFu; }
#define XB_SPIN(cond, bar) do { unsigned _sp = 0; while (cond) { __builtin_amdgcn_s_sleep(1); \
    if ((++_sp & 255u) == 0u) { if (xb_ld(&(bar)[XB_TMO])) break; if (_sp > XB_SPIN_CAP) { atomicAdd(&(bar)[XB_TMO], 1u); break; } } } } while (0)
struct XcdBarrier { unsigned* bar; unsigned x; volatile unsigned* st; };
__device__ __forceinline__ XcdBarrier xcd_barrier_post(unsigned* bar, volatile unsigned* st) {
    XcdBarrier b; b.bar = bar; b.x = xb_xcc_id(); b.st = st;
    if (threadIdx.x == 0) (void)xb_add(&bar[XB_XCNT(b.x)], 1u);
    return b;
}
__device__ __forceinline__ void xcd_barrier_complete(unsigned* bar, unsigned x, unsigned& nloc, unsigned& nx) {
    const unsigned G = gridDim.x * gridDim.y * gridDim.z;
    unsigned sum, cnt, mine, sp = 0u;
    for (;;) {
        sum = 0u; cnt = 0u; mine = 0u;
#pragma unroll
        for (unsigned j = 0; j < 16; ++j) { const unsigned c = xb_ld(&bar[XB_XCNT(j)]); sum += c; cnt += (c > 0u) ? 1u : 0u; mine = (j == x) ? c : mine; }
        if (sum == G) break;
        __builtin_amdgcn_s_sleep(1);
        if ((++sp & 255u) == 0u) { if (xb_ld(&bar[XB_TMO])) break; if (sp > XB_SPIN_CAP) { atomicAdd(&bar[XB_TMO], 1u); break; } }
    }
    nloc = mine > 0u ? mine : 1u; nx = cnt > 0u ? cnt : 1u;
}
__device__ __forceinline__ void xcd_barrier(const XcdBarrier& b) {
    asm volatile("s_waitcnt vmcnt(0)" ::: "memory");
    __syncthreads();
    if (threadIdx.x == 0) {
        unsigned* bar = b.bar;
        __builtin_amdgcn_s_waitcnt(0);
        unsigned nloc = b.st[0], nx = b.st[1];
        if (nloc == 0u) { xcd_barrier_complete(bar, b.x, nloc, nx); b.st[0] = nloc; b.st[1] = nx; }
        const unsigned old = xb_add(&bar[XB_XSUB(b.x)], 1u);
        const unsigned gen = old / nloc;
        if (old + 1u == (gen + 1u) * nloc) {
            __builtin_amdgcn_fence(__ATOMIC_RELEASE, "agent");
            asm volatile("s_waitcnt vmcnt(0)" ::: "memory");
            const unsigned og = xb_add(&bar[XB_TOP], 1u);
            const unsigned tg = og / nx;
            if (og + 1u == (tg + 1u) * nx) xb_add(&bar[XB_TOPGEN], 1u);
            else XB_SPIN(xb_ld(&bar[XB_TOPGEN]) == tg, bar);
            __builtin_amdgcn_fence(__ATOMIC_ACQUIRE, "agent");
            xb_add(&bar[XB_XGEN(b.x)], 1u);
            asm volatile("s_waitcnt vmcnt(0)" ::: "memory");
        } else {
            XB_SPIN(xb_ld(&bar[XB_XGEN(b.x)]) == gen, bar);
            __builtin_amdgcn_fence(__ATOMIC_ACQUIRE, "agent");
            asm volatile("s_waitcnt vmcnt(0)" ::: "memory");
        }
    }
    __syncthreads();
}

constexpr int NPH = 1 + 2 * 9 + 1;
__global__ void __launch_bounds__(512, 2) mega(Params P, int ph_lo, int ph_hi) {
    extern __shared__ __attribute__((aligned(16))) unsigned char smem[];
    cg::grid_group grid = cg::this_grid();
    unsigned char* ws = P.ws;
    LAS unsigned char* lds = (LAS unsigned char*)smem;
    volatile unsigned* xst = (volatile unsigned*)(smem + LDS_BYTES - 32);
    if (threadIdx.x == 0) { xst[0] = 0u; xst[1] = 0u; }
    __syncthreads();
    XcdBarrier xbar = xcd_barrier_post((unsigned*)(ws + WS_CTL) + 4096, xst);
    int ph = 0;
#ifndef PHMASK
#define PHMASK 0xffff
#endif
#define RUN(cat, ...) do { if (ph >= ph_lo && ph < ph_hi) { if ((PHMASK >> (cat)) & 1) { __VA_ARGS__; } if (ph + 1 < ph_hi) { if (ph_lo < 0) { asm volatile("s_waitcnt vmcnt(0) lgkmcnt(0)" ::: "memory"); grid.sync(); if (threadIdx.x < 64) { __builtin_amdgcn_fence(__ATOMIC_ACQUIRE, "agent"); asm volatile("s_waitcnt vmcnt(0)" ::: "memory"); } __syncthreads(); } else xcd_barrier(xbar); } } ++ph; } while (0)
    RUN(0, phase0(P, smem));
    for (int l = 0; l < 2; ++l) {
        const float* modv = (const float*)(ws + WS_MODV) + (size_t)l * 9 * 6144;
        RUN(1, phase_norm(P, l, 0));
        RUN(2, { pg8::Gemm g{(const bf16_t*)(ws + WS_H), (const bf16_t*)(ws + WS_WIN) + (size_t)l * 3072 * 1024, M, NP, D, D}; pg8::StaticOrder S; S.init(M, NP, gridDim.x, blockIdx.x);
              pg8::EpiProj E{(bf16_t*)(ws + WS_BIG), (bf16_t*)(ws + WS_HALO), P.out + O_KR, P.out + O_SK, P.out + O_SV, l};
              pg8::gemm_phase<pg8::EpiProj, true, true>(lds, g, S, E); });
        RUN(3, { unsigned* pctr = (unsigned*)(ws + WS_CTL) + 64 * (5 + l); volatile unsigned* pslot = (volatile unsigned*)(smem + LDS_BYTES - 64);
                 for (;;) {
                     if (threadIdx.x == 0) *pslot = atomicAdd(pctr, 1u);
                     __syncthreads(); const int it = (int)*pslot; __syncthreads();
                     if (it >= 1312) break;
                     if (it < 640) post_tile<1>(P, l, it, smem); else if (it < 1280) post_tile<0>(P, l, it - 640, smem); else ctx_tile(P, l, it - 1280, smem);
                 } });
        RUN(4, phase_mix(P, l, smem));
        RUN(5, phase_dnfin(P, l));
        RUN(6, { pg8::Gemm g{(const bf16_t*)(ws + WS_BIG), (const bf16_t*)(ws + WS_WOUT) + (size_t)l * 1024 * 1024, M, D, D, NP}; pg8::StaticOrder S; S.init(M, D, gridDim.x, blockIdx.x);
              pg8::EpiResid E{P.out, modv + 2048, l == 0 ? P.in[0] : nullptr, l == 0 ? P.in[1] : nullptr};
              pg8::gemm_phase<pg8::EpiResid, true, true>(lds, g, S, E); });
        RUN(1, phase_norm(P, l, 1));
        RUN(7, { pg8::Gemm g{(const bf16_t*)(ws + WS_H), (const bf16_t*)(ws + WS_WFF1) + (size_t)l * 4096 * 1024, M, FF, D, D}; pg8::StaticOrder S; S.init(M, FF, gridDim.x, blockIdx.x);
              pg8::EpiRelu2 E{(bf16_t*)(ws + WS_BIG)};
              pg8::gemm_phase<pg8::EpiRelu2, true, true>(lds, g, S, E); });
        RUN(8, { pg8::Gemm g{(const bf16_t*)(ws + WS_BIG), (const bf16_t*)(ws + WS_WFF2) + (size_t)l * 1024 * 4096, M, D, FF, FF}; pg8::StaticOrder S; S.init(M, D, gridDim.x, blockIdx.x);
              pg8::EpiResid E{P.out, modv + 5120, nullptr, nullptr};
              pg8::gemm_phase<pg8::EpiResid, true, true>(lds, g, S, E); });
    }
    RUN(9, phase_final(P));
#undef RUN
}

#ifndef PH_END
#define PH_END NPH
#endif
#ifndef MULTI_LAUNCH
#define MULTI_LAUNCH 0
#endif
extern "C" void kernel_launch(void* const* d_in, const int* in_sizes, int n_in, void* d_out, int out_size, void* d_ws, size_t ws_size, hipStream_t stream) {
    static int grid = 0;
    if (grid == 0) {
        if (n_in != 27 || ws_size < WS_END) { fprintf(stderr, "kernel_launch: unexpected n_in %d / ws_size %zu\n", n_in, ws_size); grid = -1; return; }
        int dev = 0, cus = 0, per_cu = 0;
        hipGetDevice(&dev); hipDeviceGetAttribute(&cus, hipDeviceAttributeMultiprocessorCount, dev);
        if (hipFuncSetAttribute((const void*)mega, hipFuncAttributeMaxDynamicSharedMemorySize, LDS_BYTES) != hipSuccess) { fprintf(stderr, "kernel_launch: hipFuncSetAttribute failed\n"); grid = -1; return; }
        hipOccupancyMaxActiveBlocksPerMultiprocessor(&per_cu, (const void*)mega, 512, LDS_BYTES);
        if (per_cu < 1) { fprintf(stderr, "kernel_launch: occupancy query says %d\n", per_cu); per_cu = 1; }
        (void)hipGetLastError();
        grid = cus * per_cu;
    }
    if (grid < 0) return;
    hipMemsetAsync((char*)d_ws + WS_CTL, 0, 32768, stream);
    Params p{};
    for (int i = 0; i < 27; ++i) p.in[i] = (const float*)d_in[i];
    p.out = (float*)d_out; p.ws = (unsigned char*)d_ws;
#if MULTI_LAUNCH
    for (int ph = 0; ph < PH_END; ++ph) hipLaunchKernelGGL(mega, dim3(grid), dim3(512), LDS_BYTES, stream, p, ph, ph + 1);
#else
    int lo = 0, hi = PH_END;
    void* args[] = {&p, &lo, &hi};
    hipError_t e = hipLaunchCooperativeKernel((const void*)mega, dim3(grid), dim3(512), args, LDS_BYTES, stream);
    if (e != hipSuccess) fprintf(stderr, "cooperative launch failed: %s (grid %d)\n", hipGetErrorString(e), grid);
#endif
}
```
